# Optimizing an MI355X kernel written in HIP

```python
import math
import jax, jax.numpy as jnp
from jax import lax
import numpy as np

D_MODEL = 1024
BATCH = 8
SEQ = 4096
DEPTH = 4

GRID_W = 64
CTX_LEN = 256
D_MIX = 1024
D_CONV = 512
N_HEADS_DN = 4
HEAD_DK = 128
HEAD_DV = 128
D_DN = N_HEADS_DN * HEAD_DV
CONV_W = 3
CHUNK = 64
EPS = 1e-6

PROJ_SIZES = (D_CONV, D_CONV, D_CONV, D_CONV,
              N_HEADS_DN * HEAD_DK, N_HEADS_DN * HEAD_DK, D_DN, D_DN,
              2 * N_HEADS_DN, 2 * N_HEADS_DN)
PROJ_SPLITS = tuple(int(s) for s in np.cumsum(PROJ_SIZES)[:-1])
D_PROJ = sum(PROJ_SIZES)
D_QKV = 2 * N_HEADS_DN * HEAD_DK + D_DN

kernel_name = "hybrid_conv_deltanet_dit_block"


def rms_norm(x, w):
    x32 = x.astype(jnp.float32)
    y = x32 * lax.rsqrt(jnp.mean(x32 * x32, axis=-1, keepdims=True) + EPS)
    return (y * w.astype(jnp.float32)).astype(x.dtype)


def l2_normalize(t):
    t32 = t.astype(jnp.float32)
    return t32 * lax.rsqrt(jnp.sum(t32 * t32, axis=-1, keepdims=True) + EPS)


def to_scan_order(x, col_major):
    if not col_major:
        return x
    b, n, f = x.shape
    rows = n // GRID_W
    return x.reshape(b, rows, GRID_W, f).transpose(0, 2, 1, 3).reshape(b, n, f)


def from_scan_order(x, col_major):
    if not col_major:
        return x
    b, n, f = x.shape
    rows = n // GRID_W
    return x.reshape(b, GRID_W, rows, f).transpose(0, 2, 1, 3).reshape(b, n, f)


def segment_conv(x, w, seg):
    b, n, ch = x.shape
    pad = CONV_W // 2
    xs = jnp.pad(x.reshape(b, n // seg, seg, ch), ((0, 0), (0, 0), (pad, pad), (0, 0)))
    y = w[0] * xs[:, :, 0:seg]
    for j in range(1, CONV_W):
        y = y + w[j] * xs[:, :, j:j + seg]
    return y.reshape(b, n, ch)


def split_proj(p):
    return jnp.split(p, PROJ_SPLITS, axis=-1)


def gated_delta_chunked(q, k, v, beta, g, s0, with_output):
    b, l, h, dk = q.shape
    dv = v.shape[-1]
    n = l // CHUNK

    def chunks(t):
        t = t.astype(jnp.float32).reshape((b, n, CHUNK) + t.shape[2:])
        return jnp.swapaxes(t, 2, 3)

    qc, kc, vc, bc, gch = (chunks(t) for t in (q, k, v, beta, g))
    gcum = jnp.cumsum(gch, axis=-1)
    idx = jnp.arange(CHUNK)
    incl = idx[:, None] >= idx[None, :]
    strict = idx[:, None] > idx[None, :]
    decay = jnp.exp(jnp.where(incl, gcum[..., :, None] - gcum[..., None, :], -jnp.inf))
    kk = jnp.einsum('bnhtd,bnhsd->bnhts', kc, kc)
    a_mat = jnp.where(strict, bc[..., :, None] * kk * decay, 0.0)
    rhs = jnp.concatenate([vc * bc[..., None], kc * (bc * jnp.exp(gcum))[..., None]], axis=-1)
    sol = lax.linalg.triangular_solve(a_mat + jnp.eye(CHUNK, dtype=jnp.float32), rhs,
                                      left_side=True, lower=True, unit_diagonal=True)
    u0, w = sol[..., :dv], sol[..., dv:]
    g_last = gcum[..., -1]
    k_dec = kc * jnp.exp(g_last[..., None] - gcum)[..., None]
    xs = [u0, w, k_dec, g_last]
    if with_output:
        p_intra = jnp.einsum('bnhtd,bnhsd->bnhts', qc, kc) * decay
        q_dec = qc * jnp.exp(gcum)[..., None]
        xs = xs + [p_intra, q_dec]
    xs = tuple(jnp.moveaxis(t, 1, 0) for t in xs)

    def step(s, inp):
        u0_i, w_i, kd_i, gl_i = inp[:4]
        u = u0_i - jnp.einsum('bhtk,bhkv->bhtv', w_i, s)
        s_new = s * jnp.exp(gl_i)[..., None, None] + jnp.einsum('bhtk,bhtv->bhkv', kd_i, u)
        if with_output:
            p_i, qd_i = inp[4:]
            o = jnp.einsum('bhtk,bhkv->bhtv', qd_i, s) + jnp.einsum('bhts,bhsv->bhtv', p_i, u)
            return s_new, o
        return s_new, None

    s_fin, o = lax.scan(step, s0.astype(jnp.float32), xs)
    if with_output:
        o = jnp.transpose(o, (1, 0, 3, 2, 4)).reshape(b, l, h, dv)
    return o, s_fin


def deltanet_inputs(q, k, v, beta_logit, alpha_in, conv_qkv, a_log, dt_bias, seg):
    b, n, _ = q.shape
    qkv = jax.nn.silu(segment_conv(jnp.concatenate([q, k, v], axis=-1), conv_qkv, seg))
    q, k, v = jnp.split(qkv, [N_HEADS_DN * HEAD_DK, 2 * N_HEADS_DN * HEAD_DK], axis=-1)
    q = l2_normalize(q.reshape(b, n, N_HEADS_DN, HEAD_DK)) * (HEAD_DK ** -0.5)
    k = l2_normalize(k.reshape(b, n, N_HEADS_DN, HEAD_DK))
    v = v.reshape(b, n, N_HEADS_DN, HEAD_DV).astype(jnp.float32)
    beta = jax.nn.sigmoid(beta_logit.reshape(b, n, 2, N_HEADS_DN).astype(jnp.float32))
    g = -jnp.exp(a_log.astype(jnp.float32)) * jax.nn.softplus(
        alpha_in.reshape(b, n, 2, N_HEADS_DN).astype(jnp.float32) + dt_bias.astype(jnp.float32))
    return q, k, v, beta, g


def bidirectional_gdn(dl, dc, ctx_out):
    ql, kl, vl, bl, gl = dl
    qc, kc, vc, bc, gc = dc
    s0 = jnp.zeros((ql.shape[0], N_HEADS_DN, HEAD_DK, HEAD_DV), jnp.float32)

    def flip(t):
        return jnp.flip(t, axis=1)

    oc_f, sc_f = gated_delta_chunked(qc, kc, vc, bc[:, :, 0], gc[:, :, 0], s0, ctx_out)
    ol_f, _ = gated_delta_chunked(ql, kl, vl, bl[:, :, 0], gl[:, :, 0], sc_f, True)
    oc_b, sc_b = gated_delta_chunked(flip(qc), flip(kc), flip(vc), flip(bc[:, :, 1]),
                                     flip(gc[:, :, 1]), s0, ctx_out)
    ol_b, _ = gated_delta_chunked(flip(ql), flip(kl), flip(vl), flip(bl[:, :, 1]),
                                  flip(gl[:, :, 1]), sc_b, True)
    ol = ol_f + flip(ol_b)
    oc = oc_f + flip(oc_b) if ctx_out else None
    return ol, oc


def branch_outputs(p, o_dn, conv_a, gdn_norm, seg):
    xa, bg, cg, za = p[0], p[1], p[2], p[3]
    zb = p[7]
    b, n, _ = za.shape
    ya = bg * segment_conv(cg * xa, conv_a, seg) * jax.nn.silu(za)
    yb = rms_norm(o_dn, gdn_norm) * jax.nn.silu(
        zb.reshape(b, n, N_HEADS_DN, HEAD_DV).astype(jnp.float32))
    return jnp.concatenate([ya, yb.reshape(b, n, D_DN).astype(ya.dtype)], axis=-1)


def hybrid_layer(xl, xc, c, c_ctx, norm_w, w_mod, b_mod, w_in, conv_a, conv_qkv,
                 a_log, dt_bias, gdn_norm, w_out, col_major, ctx_out):
    n = xl.shape[1]
    rows = n // GRID_W
    seg_l = rows if col_major else GRID_W
    seg_c = xc.shape[1]
    mod_l = jax.nn.silu(c) @ w_mod + b_mod
    shift_l, scale_l, gate_l = jnp.split(mod_l[:, None, :], 3, axis=-1)
    mod_c = jax.nn.silu(c_ctx) @ w_mod + b_mod
    shift_c, scale_c, gate_c = jnp.split(mod_c, 3, axis=-1)
    hl = rms_norm(xl, norm_w) * (1.0 + scale_l) + shift_l
    hc = rms_norm(xc, norm_w) * (1.0 + scale_c) + shift_c
    pl = split_proj(to_scan_order(hl, col_major) @ w_in)
    pc = split_proj(hc @ w_in)
    dl = deltanet_inputs(pl[4], pl[5], pl[6], pl[8], pl[9], conv_qkv, a_log, dt_bias, seg_l)
    dc = deltanet_inputs(pc[4], pc[5], pc[6], pc[8], pc[9], conv_qkv, a_log, dt_bias, seg_c)
    ol, oc = bidirectional_gdn(dl, dc, ctx_out)
    yl = from_scan_order(branch_outputs(pl, ol, conv_a, gdn_norm, seg_l), col_major)
    xl = xl + gate_l * (yl @ w_out)
    if ctx_out:
        yc = branch_outputs(pc, oc, conv_a, gdn_norm, seg_c)
        xc = xc + gate_c * (yc @ w_out)
    return xl, xc


def setup_inputs(seed: int = 0) -> dict:
    key = jax.random.key(seed)
    ks = jax.random.split(key, 16)
    f32 = jnp.float32
    x = jax.random.normal(ks[0], (BATCH, SEQ, D_MODEL), f32)
    c = jax.random.normal(ks[1], (BATCH, D_MODEL), f32)
    ctx = jax.random.normal(ks[2], (BATCH, CTX_LEN, D_MODEL), f32)
    c_ctx = jax.random.normal(ks[3], (D_MODEL,), f32)
    norm_w = 1.0 + 0.05 * jax.random.normal(ks[4], (DEPTH, D_MODEL), f32)
    w_mod = 0.5 * D_MODEL ** -0.5 * jax.random.normal(ks[5], (DEPTH, D_MODEL, 3 * D_MODEL), f32)
    b_mod = 0.02 * jax.random.normal(ks[6], (DEPTH, 3 * D_MODEL), f32)
    w_in = D_MODEL ** -0.5 * jax.random.normal(ks[7], (DEPTH, D_MODEL, D_PROJ), f32)
    conv_a = CONV_W ** -0.5 * jax.random.normal(ks[8], (DEPTH, CONV_W, D_CONV), f32)
    conv_qkv = CONV_W ** -0.5 * jax.random.normal(ks[9], (DEPTH, CONV_W, D_QKV), f32)
    a_log = jnp.log(jax.random.uniform(ks[10], (DEPTH, 2, N_HEADS_DN), f32, 1.0, 16.0))
    dt = jnp.exp(jax.random.uniform(ks[11], (DEPTH, 2, N_HEADS_DN), f32)
                 * (math.log(0.1) - math.log(0.001)) + math.log(0.001))
    dt_bias = dt + jnp.log(-jnp.expm1(-dt))
    gdn_norm = 1.0 + 0.05 * jax.random.normal(ks[12], (DEPTH, HEAD_DV), f32)
    w_out = D_MIX ** -0.5 * jax.random.normal(ks[13], (DEPTH, D_MIX, D_MODEL), f32)
    final_norm = 1.0 + 0.05 * jax.random.normal(ks[14], (D_MODEL,), f32)
    return {"x": x, "c": c, "ctx": ctx, "c_ctx": c_ctx, "norm_w": norm_w,
            "w_mod": w_mod, "b_mod": b_mod, "w_in": w_in, "conv_a": conv_a,
            "conv_qkv": conv_qkv, "a_log": a_log, "dt_bias": dt_bias,
            "gdn_norm": gdn_norm, "w_out": w_out, "final_norm": final_norm}


def reference(x, c, ctx, c_ctx, norm_w, w_mod, b_mod, w_in, conv_a, conv_qkv,
              a_log, dt_bias, gdn_norm, w_out, final_norm):
    xl, xc = x, ctx
    for i in range(DEPTH):
        xl, xc = hybrid_layer(xl, xc, c, c_ctx, norm_w[i], w_mod[i], b_mod[i], w_in[i],
                              conv_a[i], conv_qkv[i], a_log[i], dt_bias[i], gdn_norm[i],
                              w_out[i], col_major=(i % 2 == 1), ctx_out=(i < DEPTH - 1))
    return rms_norm(xl, final_norm)
```

```cpp
#include <hip/hip_runtime.h>
#include <hip/hip_cooperative_groups.h>
#include <cstdio>
namespace cg = cooperative_groups;

#ifndef N_LAUNCH_MODE
#define N_LAUNCH_MODE 1
#endif

typedef unsigned short bf16_t;
typedef short bf16x8 __attribute__((ext_vector_type(8)));
typedef float f32x4 __attribute__((ext_vector_type(4)));
typedef unsigned u32x4 __attribute__((ext_vector_type(4)));
typedef unsigned u32x2 __attribute__((ext_vector_type(2)));

constexpr int LROWS = 8 * 4096;
constexpr int MROWS = LROWS + 8 * 256;
constexpr int DPROJ = 4112;
constexpr int NPADW = 4224;
constexpr int PRE_TASK = 57344;
constexpr int NTASK_C = 8 * 4 * 68;
constexpr int LDS_BYTES = 73728;
constexpr int NPHASE = 30;

struct Params {
  const float *x, *c, *ctx, *c_ctx, *norm_w, *w_mod, *b_mod, *w_in, *conv_a, *conv_qkv, *a_log, *dt_bias, *gdn_norm, *w_out, *final_norm;
  float *out, *XC, *MOD, *BA, *SC;
  bf16_t *WtIn, *WtOut, *H, *PQKV, *PZB, *PRE;
  unsigned* bar;
  int phase_lo, phase_hi;
};

__device__ __forceinline__ float bf2f(bf16_t u) { return __uint_as_float(((unsigned)u) << 16); }
typedef __bf16 bf16x2_t __attribute__((ext_vector_type(2)));
typedef float f32x2_t __attribute__((ext_vector_type(2)));
__device__ __forceinline__ unsigned pack2(float lo, float hi) { f32x2_t v = {lo, hi}; bf16x2_t b = __builtin_convertvector(v, bf16x2_t); return __builtin_bit_cast(unsigned, b); }
__device__ __forceinline__ bf16_t f2bf(float f) { return (bf16_t)(pack2(f, 0.f) & 0xffffu); }
__device__ __forceinline__ float bflo(unsigned u) { return __uint_as_float(u << 16); }
__device__ __forceinline__ float bfhi(unsigned u) { return __uint_as_float(u & 0xffff0000u); }
__device__ __forceinline__ void unpack8(const uint4& u, float* f) {
  f[0] = bflo(u.x); f[1] = bfhi(u.x); f[2] = bflo(u.y); f[3] = bfhi(u.y);
  f[4] = bflo(u.z); f[5] = bfhi(u.z); f[6] = bflo(u.w); f[7] = bfhi(u.w);
}
__device__ __forceinline__ uint4 pack8(const float* f) {
  uint4 u; u.x = pack2(f[0], f[1]); u.y = pack2(f[2], f[3]); u.z = pack2(f[4], f[5]); u.w = pack2(f[6], f[7]); return u;
}
__device__ __forceinline__ float silu_f(float v) { return v * __builtin_amdgcn_rcpf(1.f + __expf(-v)); }
__device__ __forceinline__ f32x4 mfma16(bf16x8 a, bf16x8 b, f32x4 c) { return __builtin_amdgcn_mfma_f32_16x16x32_bf16(a, b, c, 0, 0, 0); }


__device__ __forceinline__ size_t kb_off(int row, int k8) {
  const int r = row & 127, c = (k8 >> 3) & 3;
  return (size_t)((row >> 7) * 32 + (k8 >> 5)) * 4096 + (r >> 2) * 128 + (r & 3) * 32 + ((c ^ ((r >> 2) & 3)) * 8);
}

__device__ void phase_mod(const Params& p, char* smem, int bid, int nblk) {
  float* s = (float*)smem;
  float* part = s + 9 * 1024;
  int tid = threadIdx.x; asm volatile("" : "+v"(tid));
  const int w = tid >> 6, lane = tid & 63;
  if (bid >= 192) return;
  for (int i = tid; i < 9 * 1024; i += 256) {
    int r = i >> 10, k = i & 1023;
    float v = r < 8 ? p.c[r * 1024 + k] : p.c_ctx[k];
    s[i] = silu_f(v);
  }
  __syncthreads();
  for (int t = bid; t < 192; t += nblk) {
    const int l = t / 48, j0 = (t % 48) * 64;
    const float* W = p.w_mod + (size_t)l * 1024 * 3072 + j0 + lane;
    float acc[9];
#pragma unroll
    for (int r = 0; r < 9; ++r) acc[r] = 0.f;
#pragma unroll 32
    for (int k = w * 256; k < w * 256 + 256; ++k) {
      float wv = W[(size_t)k * 3072];
#pragma unroll
      for (int r = 0; r < 9; ++r) acc[r] += s[r * 1024 + k] * wv;
    }
#pragma unroll
    for (int r = 0; r < 9; ++r) part[(w * 9 + r) * 64 + lane] = acc[r];
    __syncthreads();
    for (int i = tid; i < 576; i += 256) {
      int r = i >> 6, jj = i & 63;
      float v = part[(0 * 9 + r) * 64 + jj] + part[(1 * 9 + r) * 64 + jj] + part[(2 * 9 + r) * 64 + jj] + part[(3 * 9 + r) * 64 + jj];
      p.MOD[(size_t)(l * 9 + r) * 3072 + j0 + jj] = v + p.b_mod[l * 3072 + j0 + jj];
    }
    __syncthreads();
  }
}

__device__ void conv_weights(const Params& p, int l, char* smem, int bid, int nblk) {
  float* tile = (float*)smem;
  int tid = threadIdx.x; asm volatile("" : "+v"(tid));
  const int w = tid >> 6, lane = tid & 63;
  bf16_t* WtInL = p.WtIn + (size_t)(l & 1) * NPADW * 1024;
  bf16_t* WtOutL = p.WtOut + (size_t)(l & 1) * 1024 * 1024;
  {
    const float* srcp = p.w_in + (size_t)l * 1024 * DPROJ;
    for (int t = bid; t < 1056; t += nblk) {
      const int n0 = (t >> 4) * 64, k0 = (t & 15) * 64;
      for (int i = w; i < 64; i += 4) { int n = n0 + lane; tile[i * 65 + lane] = n < DPROJ ? srcp[(size_t)(k0 + i) * DPROJ + n] : 0.f; }
      __syncthreads();
      for (int i = w; i < 64; i += 4) {
        int n = n0 + i;
        if (n < 2048) {
          const int ssrc = n >> 9, ch = n & 511, jj = (ssrc == 1) ? 2 : (ssrc == 2 ? 1 : ssrc);
          n = (ch >> 5) * 128 + ((ch >> 4) & 1) * 64 + (ch & 3) * 16 + ((ch >> 2) & 3) * 4 + jj;
        } else {
          const int c = (n - 2048) & 127, base = (n - 2048) & ~127;
          n = 2048 + base + (c >> 6) * 64 + ((c >> 2) & 3) * 16 + ((c >> 4) & 3) * 4 + (c & 3);
        }
        WtInL[kb_off(n, (k0 + lane) & ~7) + (lane & 7)] = f2bf(tile[lane * 65 + i]);
      }
      __syncthreads();
    }
  }
  {
    const float* srcp = p.w_out + (size_t)l * 1024 * 1024;
    for (int t = bid + ((1056 - bid + nblk - 1) / nblk) * nblk - 1056; t < 256; t += nblk) {
      const int n0 = (t >> 4) * 64, k0 = (t & 15) * 64;
      for (int i = w; i < 64; i += 4) tile[i * 65 + lane] = srcp[(size_t)(k0 + i) * 1024 + n0 + lane];
      __syncthreads();
      for (int i = w; i < 64; i += 4) WtOutL[kb_off(n0 + i, (k0 + lane) & ~7) + (lane & 7)] = f2bf(tile[lane * 65 + i]);
      __syncthreads();
    }
  }
}

__device__ void phase_prep(const Params& p, int l, char* smem, int bid, int nblk) {
  int tid = threadIdx.x; asm volatile("" : "+v"(tid));
  const int w = tid >> 6, lane = tid & 63;
  const int gw = bid * 4 + w, nw = nblk * 4;
  const float* nwp = p.norm_w + l * 1024;
  const int R0 = (int)(((long)gw * MROWS) / nw), R1 = (int)(((long)(gw + 1) * MROWS) / nw);
  float4 am[4], sh[4];
  int bcur = -1;
  for (int row = R0; row < R1; ++row) {
    const float* src; int b, dstrow;
    if (row < LROWS) {
      b = row >> 12; int t = row & 4095;
      src = (l == 0 ? p.x : p.out) + (size_t)row * 1024;
      int ts = (l & 1) ? ((t & 63) * 64 + (t >> 6)) : t;
      dstrow = b * 4096 + ts;
    } else {
      b = 8; src = (l == 0 ? p.ctx : p.XC) + (size_t)(row - LROWS) * 1024; dstrow = row;
    }
    float4 v[4]; float ss = 0.f;
#pragma unroll
    for (int i = 0; i < 4; ++i) {
      v[i] = *(const float4*)(src + i * 256 + lane * 4);
      ss += v[i].x * v[i].x + v[i].y * v[i].y + v[i].z * v[i].z + v[i].w * v[i].w;
    }
    if (b != bcur) {
      bcur = b;
      const float* md = p.MOD + (size_t)(l * 9 + b) * 3072;
#pragma unroll
      for (int i = 0; i < 4; ++i) {
        const int cidx = i * 256 + lane * 4;
        const float4 nv = *(const float4*)(nwp + cidx), sc = *(const float4*)(md + 1024 + cidx);
        sh[i] = *(const float4*)(md + cidx);
        am[i].x = nv.x * (1.f + sc.x); am[i].y = nv.y * (1.f + sc.y); am[i].z = nv.z * (1.f + sc.z); am[i].w = nv.w * (1.f + sc.w);
      }
    }
#pragma unroll
    for (int o = 32; o >= 1; o >>= 1) ss += __shfl_xor(ss, o);
    const float rstd = rsqrtf(ss * (1.f / 1024.f) + 1e-6f);
#pragma unroll
    for (int i = 0; i < 4; ++i) {
      const int cidx = i * 256 + lane * 4;
      float h0 = v[i].x * rstd * am[i].x + sh[i].x;
      float h1 = v[i].y * rstd * am[i].y + sh[i].y;
      float h2 = v[i].z * rstd * am[i].z + sh[i].z;
      float h3 = v[i].w * rstd * am[i].w + sh[i].w;
      uint2 o2; o2.x = pack2(h0, h1); o2.y = pack2(h2, h3);
      *(uint2*)(p.H + kb_off(dstrow, cidx & ~7) + (cidx & 7)) = o2;
    }
  }
}

template <int MODE>
__device__ void phase_gemm(const Params& p, int l, char* smem, int bid, int nblk) {
  constexpr int NT = MODE == 0 ? 17 : (MODE == 1 ? 16 : 8);
  const int MT = (l == 3 && MODE != 0) ? 256 : 272;
  const bf16_t* A = p.H;
  const bf16_t* WtInL = p.WtIn + (size_t)(l & 1) * NPADW * 1024;
  const bf16_t* Bt = MODE == 2 ? p.WtOut + (size_t)(l & 1) * 1024 * 1024 : WtInL;
  char* As = smem;
  char* Bs = smem + 49152;
  int tid = threadIdx.x; asm volatile("" : "+v"(tid));
  const int lane = tid & 63, w = __builtin_amdgcn_readfirstlane(tid >> 6), wr = w >> 1, wc = w & 1, i16 = lane & 15, q4 = lane >> 4;
  const int fbase = (i16 >> 2) * 256 + (i16 & 3) * 64 + ((q4 ^ (i16 >> 2)) * 16);
  const int xcd = bid & 7, jb = bid >> 3, nb8 = nblk >> 3;
  if (jb >= nb8) return;
  const bool use_small = (MODE == 2) && (MT == 272);
  const int nbig = (use_small ? 16 : (MT >> 4)) * NT;
  const int nloc = nbig + (use_small ? 2 * NT : 0);
  const int bpanel0 = MODE == 0 ? 16 : 0;
  for (int tq = jb; tq < nloc; tq += nb8) {
    f32x4 acc[8][4];
#pragma unroll
    for (int i = 0; i < 8; ++i)
#pragma unroll
      for (int j = 0; j < 4; ++j) acc[i][j] = (f32x4){0.f, 0.f, 0.f, 0.f};
    if (MODE == 2 && tq >= nbig) {
      const int s_ = tq - nbig;
      const int panel = (16 * 8 + xcd) * 2 + s_ / NT, nts = s_ % NT;
      const bf16_t* Ag = A + (size_t)panel * 32 * 4096 + tid * 8;
      const bf16_t* Bg = Bt + (size_t)(bpanel0 + nts) * 32 * 4096 + tid * 8;
#define DMA_S(KS, ST) do { _Pragma("unroll") for (int i = 0; i < 2; ++i) { \
        __builtin_amdgcn_global_load_lds((const unsigned*)(Ag + (size_t)(KS) * 4096 + i * 2048), (__attribute__((address_space(3))) unsigned*)(As + (ST) * 16384 + i * 4096 + tid * 16), 16, 0, 0); \
        __builtin_amdgcn_global_load_lds((const unsigned*)(Bg + (size_t)(KS) * 4096 + i * 2048), (__attribute__((address_space(3))) unsigned*)(Bs + (ST) * 8192 + i * 4096 + tid * 16), 16, 0, 0); } } while (0)
#define STEP_S(S, ST, STN) do { \
        asm volatile("s_waitcnt vmcnt(4)" ::: "memory"); \
        __builtin_amdgcn_s_barrier(); \
        asm volatile("" ::: "memory"); \
        { const int ks = (S) + 2 < 32 ? (S) + 2 : 31; DMA_S(ks, STN); } \
        { const char* Ab = As + (ST) * 16384 + fbase; const char* Bb = Bs + (ST) * 8192 + w * 2048 + fbase; \
          bf16x8 bfr[2]; \
          bfr[0] = *(const bf16x8*)(Bb); bfr[1] = *(const bf16x8*)(Bb + 1024); \
          _Pragma("unroll") for (int mh = 0; mh < 2; ++mh) { bf16x8 af[4]; \
            _Pragma("unroll") for (int mi = 0; mi < 4; ++mi) af[mi] = *(const bf16x8*)(Ab + (mh * 4 + mi) * 1024); \
            _Pragma("unroll") for (int mi = 0; mi < 4; ++mi) { acc[mh * 4 + mi][0] = mfma16(bfr[0], af[mi], acc[mh * 4 + mi][0]); acc[mh * 4 + mi][1] = mfma16(bfr[1], af[mi], acc[mh * 4 + mi][1]); } \
            __builtin_amdgcn_sched_barrier(0); } } } while (0)
      DMA_S(0, 0); DMA_S(1, 1);
#pragma unroll 1
      for (int s3 = 0; s3 < 30; s3 += 3) { STEP_S(s3, 0, 2); STEP_S(s3 + 1, 1, 0); STEP_S(s3 + 2, 2, 1); }
      STEP_S(30, 0, 2); STEP_S(31, 1, 0);
      asm volatile("s_waitcnt vmcnt(0)" ::: "memory");
      __builtin_amdgcn_s_barrier();
      asm volatile("" ::: "memory");
#undef DMA_S
#undef STEP_S
#pragma unroll
      for (int mi = 0; mi < 8; ++mi) {
        const int row = panel * 128 + mi * 16 + i16;
        if (MODE == 2) {
          const float* srcp; float* dstp; int b;
          if (row < LROWS) {
            b = row >> 12; int ts = row & 4095;
            int tt = (l & 1) ? ((ts & 63) * 64 + (ts >> 6)) : ts;
            size_t off = (size_t)(b * 4096 + tt) * 1024;
            srcp = (l == 0 ? p.x : p.out) + off; dstp = p.out + off;
          } else {
            b = 8; size_t off = (size_t)(row - LROWS) * 1024;
            srcp = (l == 0 ? p.ctx : p.XC) + off; dstp = p.XC + off;
          }
          const float* gate = p.MOD + (size_t)(l * 9 + b) * 3072 + 2048;
#pragma unroll
          for (int ni = 0; ni < 2; ++ni) {
            const int n = nts * 128 + w * 32 + ni * 16 + q4 * 4;
            float4 xv = *(const float4*)(srcp + n), gv = *(const float4*)(gate + n);
            float4 o; o.x = xv.x + gv.x * acc[mi][ni][0]; o.y = xv.y + gv.y * acc[mi][ni][1]; o.z = xv.z + gv.z * acc[mi][ni][2]; o.w = xv.w + gv.w * acc[mi][ni][3];
            *(float4*)(dstp + n) = o;
          }
        } else if (MODE == 1) {
          u32x2 o2;
          o2[0] = pack2(acc[mi][0][0] * acc[mi][0][1], acc[mi][0][2] * silu_f(acc[mi][0][3]));
          o2[1] = pack2(acc[mi][1][0] * acc[mi][1][1], acc[mi][1][2] * silu_f(acc[mi][1][3]));
          *(u32x2*)(p.PRE + (size_t)row * 1024 + (nts * 32 + (w >> 1) * 16 + q4 * 4 + (w & 1) * 2) * 2) = o2;
        }
      }
      continue;
    }
    const int mt2 = (tq / NT) * 8 + xcd, nt = tq % NT;
    const bf16_t* Ag = A + (size_t)(mt2 * 2) * 32 * 4096 + tid * 8;
    const bf16_t* Bg = Bt + (size_t)(bpanel0 + nt) * 32 * 4096 + tid * 8;
#define DMA_STEP(KS, ST) do { _Pragma("unroll") for (int i = 0; i < 2; ++i) { \
      __builtin_amdgcn_global_load_lds((const unsigned*)(Ag + (size_t)(KS) * 4096 + i * 2048), (__attribute__((address_space(3))) unsigned*)(As + (ST) * 16384 + i * 4096 + tid * 16), 16, 0, 0); \
      __builtin_amdgcn_global_load_lds((const unsigned*)(Ag + (size_t)(32 + (KS)) * 4096 + i * 2048), (__attribute__((address_space(3))) unsigned*)(As + (ST) * 16384 + 8192 + i * 4096 + tid * 16), 16, 0, 0); \
      __builtin_amdgcn_global_load_lds((const unsigned*)(Bg + (size_t)(KS) * 4096 + i * 2048), (__attribute__((address_space(3))) unsigned*)(Bs + (ST) * 8192 + i * 4096 + tid * 16), 16, 0, 0); } } while (0)
#define COMPUTE(ST) do { const char* Ab = As + (ST) * 16384 + wr * 8192 + fbase; const char* Bb = Bs + (ST) * 8192 + wc * 4096 + fbase; \
      bf16x8 af[8], bfr[4]; \
      _Pragma("unroll") for (int mi = 0; mi < 8; ++mi) af[mi] = *(const bf16x8*)(Ab + mi * 1024); \
      _Pragma("unroll") for (int ni = 0; ni < 4; ++ni) bfr[ni] = *(const bf16x8*)(Bb + ni * 1024); \
      __builtin_amdgcn_s_setprio(1); \
      _Pragma("unroll") for (int mi = 0; mi < 8; ++mi) _Pragma("unroll") for (int ni = 0; ni < 4; ++ni) acc[mi][ni] = mfma16(bfr[ni], af[mi], acc[mi][ni]); \
      __builtin_amdgcn_s_setprio(0); } while (0)
#define STEP(S, ST, STN) do { \
      asm volatile("s_waitcnt vmcnt(6)" ::: "memory");     \
      __builtin_amdgcn_s_barrier();                        \
      asm volatile("" ::: "memory"); \
      { const int ks = (S) + 2 < 32 ? (S) + 2 : 31; DMA_STEP(ks, STN); }     \
      COMPUTE(ST); } while (0)
    DMA_STEP(0, 0); DMA_STEP(1, 1);
#pragma unroll 1
    for (int s3 = 0; s3 < 30; s3 += 3) {
      STEP(s3, 0, 2); STEP(s3 + 1, 1, 0); STEP(s3 + 2, 2, 1);
    }
    STEP(30, 0, 2); STEP(31, 1, 0);
    asm volatile("s_waitcnt vmcnt(0)" ::: "memory");
    __builtin_amdgcn_s_barrier();
    asm volatile("" ::: "memory");
#undef DMA_STEP
#undef COMPUTE
#undef STEP
#pragma unroll
    for (int mi = 0; mi < 8; ++mi) {
      const int row = (mt2 * 2 + wr) * 128 + mi * 16 + i16;
      if (MODE == 2) {
        const float* srcp; float* dstp; int b;
        if (row < LROWS) {
          b = row >> 12; int ts = row & 4095;
          int tt = (l & 1) ? ((ts & 63) * 64 + (ts >> 6)) : ts;
          size_t off = (size_t)(b * 4096 + tt) * 1024;
          srcp = (l == 0 ? p.x : p.out) + off; dstp = p.out + off;
        } else {
          b = 8; size_t off = (size_t)(row - LROWS) * 1024;
          srcp = (l == 0 ? p.ctx : p.XC) + off; dstp = p.XC + off;
        }
        const float* gate = p.MOD + (size_t)(l * 9 + b) * 3072 + 2048;
#pragma unroll
        for (int ni = 0; ni < 4; ++ni) {
          const int n = nt * 128 + wc * 64 + ni * 16 + q4 * 4;
          float4 xv = *(const float4*)(srcp + n), gv = *(const float4*)(gate + n);
          float4 o; o.x = xv.x + gv.x * acc[mi][ni][0]; o.y = xv.y + gv.y * acc[mi][ni][1]; o.z = xv.z + gv.z * acc[mi][ni][2]; o.w = xv.w + gv.w * acc[mi][ni][3];
          *(float4*)(dstp + n) = o;
        }
      } else if (MODE == 1) {
        u32x4 o4;
#pragma unroll
        for (int ni = 0; ni < 4; ++ni) o4[ni] = pack2(acc[mi][ni][0] * acc[mi][ni][1], acc[mi][ni][2] * silu_f(acc[mi][ni][3]));
        *(u32x4*)(p.PRE + (size_t)row * 1024 + (nt * 32 + wc * 16 + q4 * 4) * 2) = o4;
      } else {
        const int n0 = nt * 128 + wc * 64 + q4 * 16;
        u32x4 lo, hi;
        lo[0] = pack2(acc[mi][0][0], acc[mi][0][1]); lo[1] = pack2(acc[mi][0][2], acc[mi][0][3]); lo[2] = pack2(acc[mi][1][0], acc[mi][1][1]); lo[3] = pack2(acc[mi][1][2], acc[mi][1][3]);
        hi[0] = pack2(acc[mi][2][0], acc[mi][2][1]); hi[1] = pack2(acc[mi][2][2], acc[mi][2][3]); hi[2] = pack2(acc[mi][3][0], acc[mi][3][1]); hi[3] = pack2(acc[mi][3][2], acc[mi][3][3]);
        if (n0 < 1536) {
          bf16_t* d = p.PQKV + (size_t)row * 1536 + n0;
          *(u32x4*)d = lo; *(u32x4*)(d + 8) = hi;
        } else if (n0 < 2048) {
          bf16_t* d = p.PZB + (size_t)row * 512 + (n0 - 1536);
          *(u32x4*)d = lo; *(u32x4*)(d + 8) = hi;
        } else if (n0 == 2048) {
          float* d = p.BA + (size_t)row * 16;
#pragma unroll
          for (int ni = 0; ni < 4; ++ni) *(f32x4*)(d + ni * 4) = acc[mi][ni];
        }
      }
    }
  }
}


__device__ __forceinline__ int fo_w(int r, int k8)  { return ((r >> 4) * 4 + (k8 >> 2)) * 64 + (k8 & 3) * 16 + (r & 15); }
__device__ __forceinline__ int fo_kT(int k, int t8) { return ((k >> 4) * 2 + (t8 >> 2)) * 64 + (t8 & 3) * 16 + (k & 15); }
__device__ __forceinline__ int fo_u0(int v, int r4) { return ((v >> 4) * 4 + (r4 >> 2)) * 64 + (r4 & 3) * 16 + (v & 15); }

__device__ void phase_pre(const Params& p, int l, char* smem, int bid, int nblk) {
  float* Am = (float*)smem;
  float* sbeta = Am + 64 * 64;
  float* sgc = sbeta + 128;
  float* sbk = sgc + 128;
  float* Tm = sbk + 128;
  bf16_t* qs = (bf16_t*)(Tm + 1024);
  bf16_t* ks = qs + 64 * 136;
  bf16_t* vs = ks + 64 * 136;
  int tid = threadIdx.x; asm volatile("" : "+v"(tid));
  const int lane = tid & 63, w = tid >> 6, i16 = lane & 15, q4 = lane >> 4;
  const float* cwp = p.conv_qkv + (size_t)l * 3 * 1536;
  for (int task = bid; task < NTASK_C; task += nblk) {
    const int b = task / 272, rem = task % 272, h = rem / 68, c = rem % 68;
    const int row0 = c < 64 ? b * 4096 + c * 64 : LROWS + b * 256 + (c - 64) * 64;
    const bool halo_lo = c > 64, halo_hi = (c >= 64 && c < 67);
    bf16_t* PREt = p.PRE + (size_t)task * PRE_TASK;
    {
      const int rg = tid >> 4, cgp = tid & 15;
      uint4 raw[3][6];
#define PRE_RAW_LOAD(MAT) do { _Pragma("unroll") for (int i = 0; i < 6; ++i) { \
          const int lr = rg * 4 - 1 + i; \
          const bool valid = (lr >= 0 || halo_lo) && (lr <= 63 || halo_hi); \
          raw[MAT][i] = make_uint4(0, 0, 0, 0); \
          if (valid) raw[MAT][i] = *(const uint4*)(p.PQKV + (size_t)(row0 + lr) * 1536 + (MAT) * 512 + h * 128 + cgp * 8); } } while (0)
      PRE_RAW_LOAD(0); PRE_RAW_LOAD(1);
      if (w < 2) {
        const int d = w;
        const int tok = d ? 63 - lane : lane;
        const float* ba = p.BA + (size_t)(row0 + tok) * 16;
        const float bl = ba[d * 4 + h], al = ba[8 + d * 4 + h];
        const float beta = 1.f / (1.f + __expf(-bl));
        const float xx = al + p.dt_bias[l * 8 + d * 4 + h];
        const float sp = fmaxf(xx, 0.f) + log1pf(__expf(-fabsf(xx)));
        float g = -__expf(p.a_log[l * 8 + d * 4 + h]) * sp;
#pragma unroll
        for (int o = 1; o < 64; o <<= 1) { float t = __shfl_up(g, o); if (lane >= o) g += t; }
        const float gl = __shfl(g, 63);
        const float eg = __expf(g);
        sbeta[d * 64 + lane] = beta; sgc[d * 64 + lane] = g; sbk[d * 64 + lane] = beta * eg;
        float* SCt = p.SC + (size_t)(task * 2 + d) * 192;
        SCt[lane] = eg; SCt[64 + lane] = __expf(gl - g);
        if (lane == 0) SCt[128] = __expf(gl);
      }
#pragma unroll
      for (int mat = 0; mat < 3; ++mat) {
        if (mat == 1) { PRE_RAW_LOAD(2); }
        const int colbase = mat * 512 + h * 128 + cgp * 8;
        float cw[3][8];
#pragma unroll
        for (int j = 0; j < 3; ++j) {
          float4 a = *(const float4*)(cwp + j * 1536 + colbase), bq = *(const float4*)(cwp + j * 1536 + colbase + 4);
          cw[j][0] = a.x; cw[j][1] = a.y; cw[j][2] = a.z; cw[j][3] = a.w; cw[j][4] = bq.x; cw[j][5] = bq.y; cw[j][6] = bq.z; cw[j][7] = bq.w;
        }
        float xr[6][8];
#pragma unroll
        for (int i = 0; i < 6; ++i) unpack8(raw[mat][i], xr[i]);
#pragma unroll
        for (int i = 0; i < 4; ++i) {
          float y[8]; float ss = 0.f;
#pragma unroll
          for (int e = 0; e < 8; ++e) {
            float t = cw[0][e] * xr[i][e] + cw[1][e] * xr[i + 1][e] + cw[2][e] * xr[i + 2][e];
            t = silu_f(t); y[e] = t; ss += t * t;
          }
          if (mat < 2) {
            ss += __shfl_xor(ss, 1); ss += __shfl_xor(ss, 2); ss += __shfl_xor(ss, 4); ss += __shfl_xor(ss, 8);
            float rs = rsqrtf(ss + 1e-6f) * (mat == 0 ? 0.08838834764831845f : 1.f);
#pragma unroll
            for (int e = 0; e < 8; ++e) y[e] *= rs;
          }
          const int r = rg * 4 + i;
          uint4 o = pack8(y);
          if (mat == 0) *(uint4*)(qs + r * 136 + cgp * 8) = o;
          else if (mat == 1) *(uint4*)(ks + r * 136 + cgp * 8) = o;
          else *(uint4*)(vs + r * 128 + cgp * 8) = o;
        }
        __builtin_amdgcn_sched_barrier(0);
      }
#undef PRE_RAW_LOAD
    }
    __syncthreads();
    {
#pragma unroll
      for (int i = 0; i < 4; ++i) {
        const int u = tid + i * 256;
        const int blk = u >> 6, qq = (u >> 4) & 3, ii = u & 15;
        const int row = (blk >> 2) * 16 + ii, cc = (blk & 3) * 4 + qq;
        *(uint4*)(PREt + u * 8) = *(const uint4*)(qs + row * 136 + cc * 8);
        const int kidx = (blk >> 1) * 16 + ii, tg = (blk & 1) * 4 + qq;
        float f[8];
#pragma unroll
        for (int e = 0; e < 8; ++e) f[e] = bf2f(ks[(tg * 8 + e) * 136 + kidx]);
        *(uint4*)(PREt + 8192 + u * 8) = pack8(f);
      }
    }
#pragma unroll 1
    for (int d = 0; d < 2; ++d) {
      bf16_t* dirb = PREt + 16384 + d * 20480;
      const float* sbeta_d = sbeta + d * 64; const float* sgc_d = sgc + d * 64; const float* sbk_d = sbk + d * 64;
      __syncthreads();
      {
        bf16x8 ktf[4], qtf[4];
#pragma unroll
        for (int kk = 0; kk < 4; ++kk) {
          ktf[kk] = *(const bf16x8*)(ks + (16 * w + i16) * 136 + kk * 32 + q4 * 8);
          qtf[kk] = *(const bf16x8*)(qs + (16 * w + i16) * 136 + kk * 32 + q4 * 8);
        }
        const int t = 16 * w + i16;
        const int r = d ? 63 - t : t;
        const float gr = sgc_d[r], br = sbeta_d[r];
#pragma unroll
        for (int st = 0; st < 4; ++st) {
          f32x4 kkr = (f32x4){0.f, 0.f, 0.f, 0.f}, qkr = (f32x4){0.f, 0.f, 0.f, 0.f};
#pragma unroll
          for (int kk = 0; kk < 4; ++kk) {
            bf16x8 ksf = *(const bf16x8*)(ks + (16 * st + i16) * 136 + kk * 32 + q4 * 8);
            kkr = mfma16(ksf, ktf[kk], kkr);
            qkr = mfma16(ksf, qtf[kk], qkr);
          }
          float pv[4];
#pragma unroll
          for (int jj = 0; jj < 4; ++jj) {
            const int s = 16 * st + 4 * q4 + jj;
            const int cd = d ? 63 - s : s;
            const float dec = __expf(fminf(gr - sgc_d[cd], 0.f));
            Am[r * 64 + cd] = (r > cd) ? br * kkr[jj] * dec : 0.f;
            pv[jj] = (r >= cd) ? qkr[jj] * dec : 0.f;
          }
          uint2 o2; o2.x = pack2(pv[0], pv[1]); o2.y = pack2(pv[2], pv[3]);
          *(uint2*)(dirb + 16384 + fo_kT(r, 2 * st + (q4 >> 1)) * 8 + (q4 & 1) * 4) = o2;
        }
      }
      __syncthreads();
      if (w == 0) {
        const int bi = lane >> 4, j = lane & 15;
        const float* Ab = Am + (16 * bi) * 64 + 16 * bi;
        float t[16];
#pragma unroll
        for (int r = 0; r < 16; ++r) {
          float a = (r == j) ? 1.f : 0.f;
#pragma unroll
          for (int c = 0; c < r; ++c) a -= Ab[r * 64 + c] * t[c];
          t[r] = a;
        }
#pragma unroll
        for (int r = 0; r < 16; ++r) Tm[(bi * 16 + r) * 16 + j] = t[r];
      }
      __syncthreads();
      {
        const bool isk = w >= 2;
        bf16x8 Aop[6], Top[4];
        {
          int pi = 0;
#pragma unroll
          for (int i = 1; i < 4; ++i)
#pragma unroll
            for (int j = 0; j < i; ++j) {
              const float4 a = *(const float4*)(Am + (16 * i + i16) * 64 + 16 * j + 4 * q4);
              u32x4 u; u[0] = pack2(-a.x, -a.y); u[1] = pack2(-a.z, -a.w); u[2] = 0u; u[3] = 0u;
              Aop[pi++] = __builtin_bit_cast(bf16x8, u);
            }
#pragma unroll
          for (int i = 0; i < 4; ++i) {
            const float4 t4 = *(const float4*)(Tm + (16 * i + i16) * 16 + 4 * q4);
            u32x4 u; u[0] = pack2(t4.x, t4.y); u[1] = pack2(t4.z, t4.w); u[2] = 0u; u[3] = 0u;
            Top[i] = __builtin_bit_cast(bf16x8, u);
          }
        }
        const float* sarr = isk ? sbk_d : sbeta_d;
        const int stride = isk ? 136 : 128;
        __syncthreads();
        bf16_t* wst = (bf16_t*)Am;
#pragma unroll 2
        for (int tt = 0; tt < 4; ++tt) {
          const int n = 64 * w + 16 * tt + i16;
          const bf16_t* sp = isk ? (ks + (n - 128)) : (vs + n);
          bf16x8 Xop[3];
#pragma unroll
          for (int i = 0; i < 4; ++i) {
            const float4 sv = *(const float4*)(sarr + 16 * i + 4 * q4);
            const int r0 = 16 * i + 4 * q4;
            f32x4 R;
            R[0] = bf2f(sp[(d ? 63 - r0 : r0) * stride]) * sv.x;
            R[1] = bf2f(sp[(d ? 62 - r0 : r0 + 1) * stride]) * sv.y;
            R[2] = bf2f(sp[(d ? 61 - r0 : r0 + 2) * stride]) * sv.z;
            R[3] = bf2f(sp[(d ? 60 - r0 : r0 + 3) * stride]) * sv.w;
#pragma unroll
            for (int j = 0; j < i; ++j) R = mfma16(Aop[i * (i - 1) / 2 + j], Xop[j], R);
            u32x4 ur; ur[0] = pack2(R[0], R[1]); ur[1] = pack2(R[2], R[3]); ur[2] = 0u; ur[3] = 0u;
            const f32x4 X = mfma16(Top[i], __builtin_bit_cast(bf16x8, ur), (f32x4){0.f, 0.f, 0.f, 0.f});
            u32x4 ux; ux[0] = pack2(X[0], X[1]); ux[1] = pack2(X[2], X[3]); ux[2] = 0u; ux[3] = 0u;
            if (i < 3) Xop[i] = __builtin_bit_cast(bf16x8, ux);
            if (!isk) {
              uint2 o2; o2.x = ux[0]; o2.y = ux[1];
              const int nl = (n & ~31) | (((n >> 2) & 1) * 16 + ((n >> 3) & 3) * 4 + (n & 3));
              *(uint2*)(dirb + 8192 + fo_u0(nl, r0 >> 2) * 4) = o2;
            } else {
              bf16_t* dst = wst + r0 * 128 + (n - 128);
              dst[0] = (bf16_t)(ux[0] & 0xffffu); dst[128] = (bf16_t)(ux[0] >> 16);
              dst[256] = (bf16_t)(ux[1] & 0xffffu); dst[384] = (bf16_t)(ux[1] >> 16);
            }
          }
        }
        __syncthreads();
#pragma unroll
        for (int i = 0; i < 4; ++i) {
          const int u = tid + i * 256;
          const int blk = u >> 6, qq = (u >> 4) & 3, ii = u & 15;
          const int row = (blk >> 2) * 16 + ii, cc = (blk & 3) * 4 + qq;
          *(uint4*)(dirb + u * 8) = *(const uint4*)(wst + row * 128 + cc * 8);
        }
      }
    }
    __syncthreads();
  }
}

struct ScanE { bf16x8 wf[4], qf[4]; uint2 u0[2]; float4 ed; float eg, egl; };
struct ScanL { bf16x8 pf[2], kTf[2][2]; };

__device__ __forceinline__ int scan_chunk(int n, int d) { return n < 4 ? 64 + (d ? 3 - n : n) : (d ? 63 - (n - 4) : n - 4); }

__device__ __forceinline__ void scan_load_e(const Params& p, ScanE& o, int n, int b, int h, int d, int slice, int w, int i16, int q4) {
  const int task = b * 272 + h * 68 + scan_chunk(n, d);
  const bf16_t* PREt = p.PRE + (size_t)task * PRE_TASK;
  const bf16_t* dirb = PREt + 16384 + d * 20480;
  const float* SCt = p.SC + (size_t)(task * 2 + d) * 192;
  const int r = 16 * w + i16;
  const int tok = d ? 63 - r : r;
#pragma unroll
  for (int kk = 0; kk < 4; ++kk) {
    o.wf[kk] = *(const bf16x8*)(dirb + fo_w(r, kk * 4 + q4) * 8);
    o.qf[kk] = *(const bf16x8*)(PREt + fo_w(tok, kk * 4 + q4) * 8);
  }
#pragma unroll
  for (int nt = 0; nt < 2; ++nt) o.u0[nt] = *(const uint2*)(dirb + 8192 + fo_u0(slice * 32 + 16 * nt + i16, 4 * w + q4) * 4);
  o.ed = *(const float4*)(SCt + 64 + 16 * w + 4 * q4);
  o.eg = SCt[r];
  o.egl = SCt[128];
}
__device__ __forceinline__ void scan_load_l(const Params& p, ScanL& o, int n, int b, int h, int d, int w, int i16, int q4) {
  const int task = b * 272 + h * 68 + scan_chunk(n, d);
  const bf16_t* PREt = p.PRE + (size_t)task * PRE_TASK;
  const bf16_t* dirb = PREt + 16384 + d * 20480;
  const int r = 16 * w + i16;
#pragma unroll
  for (int kk = 0; kk < 2; ++kk) {
    o.pf[kk] = *(const bf16x8*)(dirb + 16384 + fo_kT(r, kk * 4 + q4) * 8);
#pragma unroll
    for (int mt = 0; mt < 2; ++mt) o.kTf[mt][kk] = *(const bf16x8*)(PREt + 8192 + fo_kT(32 * w + 16 * mt + i16, kk * 4 + q4) * 8);
  }
}

__device__ void phase_scan(const Params& p, int l, char* smem, int bid, int nblk) {
  if (bid >= 256) return;
  bf16_t* S_lds = (bf16_t*)smem;
  bf16_t* U_lds = S_lds + 32 * 136;
  bf16_t* Ud_lds = U_lds + 32 * 72;
  int tid = threadIdx.x; asm volatile("" : "+v"(tid));
  const int lane = tid & 63, w = tid >> 6, i16 = lane & 15, q4 = lane >> 4;
  const int xcd = bid & 7, idx = bid >> 3;
  const int chain = xcd * 8 + (idx >> 2), slice = idx & 3;
  const int b = chain >> 3, h = (chain >> 1) & 3, d = chain & 1;
  bf16_t* Og = p.PQKV + (size_t)d * MROWS * 512;
  for (int i = tid; i < 32 * 136 / 2; i += 256) ((unsigned*)S_lds)[i] = 0u;
  f32x4 Sacc[2][2];
#pragma unroll
  for (int i = 0; i < 2; ++i)
#pragma unroll
    for (int j = 0; j < 2; ++j) Sacc[i][j] = (f32x4){0.f, 0.f, 0.f, 0.f};
  ScanE E0, E1; ScanL L0, L1;
  scan_load_e(p, E0, 0, b, h, d, slice, w, i16, q4);
  scan_load_l(p, L0, 0, b, h, d, w, i16, q4);
  scan_load_e(p, E1, 1, b, h, d, slice, w, i16, q4);
  scan_load_l(p, L1, 1, b, h, d, w, i16, q4);
  __syncthreads();
  auto scan_step = [&](const int n, ScanE& EC, ScanL& LC) __attribute__((always_inline)) {
    const int c = scan_chunk(n, d);
    const int row0 = c < 64 ? b * 4096 + c * 64 : LROWS + b * 256 + (c - 64) * 64;
    bf16x8 Sf[2][4];
#pragma unroll
    for (int nt = 0; nt < 2; ++nt)
#pragma unroll
      for (int kk = 0; kk < 4; ++kk) Sf[nt][kk] = *(const bf16x8*)(S_lds + (16 * nt + i16) * 136 + kk * 32 + q4 * 8);
    f32x4 accO[2];
    const float egl = EC.egl;
    __builtin_amdgcn_s_setprio(1);
#pragma unroll
    for (int nt = 0; nt < 2; ++nt) {
      f32x4 accU = (f32x4){0.f, 0.f, 0.f, 0.f};
      accO[nt] = (f32x4){0.f, 0.f, 0.f, 0.f};
#pragma unroll
      for (int kk = 0; kk < 4; ++kk) {
        accU = mfma16(EC.wf[kk], Sf[nt][kk], accU);
        accO[nt] = mfma16(Sf[nt][kk], EC.qf[kk], accO[nt]);
      }
      float u[4];
      u[0] = bflo(EC.u0[nt].x) - accU[0]; u[1] = bfhi(EC.u0[nt].x) - accU[1];
      u[2] = bflo(EC.u0[nt].y) - accU[2]; u[3] = bfhi(EC.u0[nt].y) - accU[3];
      const float e0 = EC.ed.x, e1 = EC.ed.y, e2 = EC.ed.z, e3 = EC.ed.w;
      uint2 pu, pd;
      int tb;
      if (d == 0) {
        tb = 16 * w + 4 * q4;
        pu.x = pack2(u[0], u[1]); pu.y = pack2(u[2], u[3]);
        pd.x = pack2(u[0] * e0, u[1] * e1); pd.y = pack2(u[2] * e2, u[3] * e3);
      } else {
        tb = 60 - 16 * w - 4 * q4;
        pu.x = pack2(u[3], u[2]); pu.y = pack2(u[1], u[0]);
        pd.x = pack2(u[3] * e3, u[2] * e2); pd.y = pack2(u[1] * e1, u[0] * e0);
      }
      *(uint2*)(U_lds + (16 * nt + i16) * 72 + tb) = pu;
      *(uint2*)(Ud_lds + (16 * nt + i16) * 72 + tb) = pd;
      accO[nt] *= EC.eg;
    }
    __builtin_amdgcn_s_setprio(0);
    __syncthreads();
    scan_load_e(p, EC, min(n + 2, 67), b, h, d, slice, w, i16, q4);
    {
      bf16x8 Uf[2][2], Udf[2][2];
#pragma unroll
      for (int nt = 0; nt < 2; ++nt)
#pragma unroll
        for (int kk = 0; kk < 2; ++kk) {
          Uf[nt][kk] = *(const bf16x8*)(U_lds + (16 * nt + i16) * 72 + kk * 32 + q4 * 8);
          Udf[nt][kk] = *(const bf16x8*)(Ud_lds + (16 * nt + i16) * 72 + kk * 32 + q4 * 8);
        }
#pragma unroll
      for (int nt = 0; nt < 2; ++nt) {
#pragma unroll
        for (int mt = 0; mt < 2; ++mt) {
          Sacc[mt][nt] *= egl;
#pragma unroll
          for (int kk = 0; kk < 2; ++kk) Sacc[mt][nt] = mfma16(LC.kTf[mt][kk], Udf[nt][kk], Sacc[mt][nt]);
        }
#pragma unroll
        for (int kk = 0; kk < 2; ++kk) accO[nt] = mfma16(Uf[nt][kk], LC.pf[kk], accO[nt]);
      }
      scan_load_l(p, LC, min(n + 2, 67), b, h, d, w, i16, q4);
#pragma unroll
      for (int nt = 0; nt < 2; ++nt)
#pragma unroll
        for (int mt = 0; mt < 2; ++mt) {
          uint2 ps; ps.x = pack2(Sacc[mt][nt][0], Sacc[mt][nt][1]); ps.y = pack2(Sacc[mt][nt][2], Sacc[mt][nt][3]);
          *(uint2*)(S_lds + (16 * nt + i16) * 136 + 32 * w + 16 * mt + 4 * q4) = ps;
        }
      {
        const int r = 16 * w + i16;
        const int tok = d ? 63 - r : r;
        bf16_t* orow = Og + (size_t)(row0 + tok) * 512 + h * 128 + slice * 32;
        {
          u32x4 po; po[0] = pack2(accO[0][0], accO[0][1]); po[1] = pack2(accO[0][2], accO[0][3]); po[2] = pack2(accO[1][0], accO[1][1]); po[3] = pack2(accO[1][2], accO[1][3]);
          *(u32x4*)(orow + 8 * q4) = po;
        }
      }
    }
    __syncthreads();
  };
#pragma unroll 1
  for (int n2 = 0; n2 < 68; n2 += 2) {
    scan_step(n2, E0, L0);
    scan_step(n2 + 1, E1, L1);
  }
}

__device__ void phase_y(const Params& p, int l, int bid, int nblk) {
  int tid = threadIdx.x; asm volatile("" : "+v"(tid));
  const int lane = tid & 63, w = tid >> 6;
  const int nrows = (l == 3) ? LROWS : MROWS;
  const bf16_t* PA = p.PRE;
  const bf16_t* Of = p.PQKV;
  const bf16_t* Ob = p.PQKV + (size_t)MROWS * 512;
  float cw[3][8], gn[8];
  {
    const float* ca = p.conv_a + (size_t)l * 3 * 512 + lane * 8;
#pragma unroll
    for (int j = 0; j < 3; ++j) {
      float4 a = *(const float4*)(ca + j * 512), bq = *(const float4*)(ca + j * 512 + 4);
      cw[j][0] = a.x; cw[j][1] = a.y; cw[j][2] = a.z; cw[j][3] = a.w; cw[j][4] = bq.x; cw[j][5] = bq.y; cw[j][6] = bq.z; cw[j][7] = bq.w;
    }
    const float* gp = p.gdn_norm + l * 128 + (lane & 15) * 8;
    float4 a = *(const float4*)gp, bq = *(const float4*)(gp + 4);
    gn[0] = a.x; gn[1] = a.y; gn[2] = a.z; gn[3] = a.w; gn[4] = bq.x; gn[5] = bq.y; gn[6] = bq.z; gn[7] = bq.w;
  }
  {
    const int gw = bid * 4 + w, nw = nblk * 4;
    const int R0 = (int)(((long)gw * nrows) / nw), R1 = (int)(((long)(gw + 1) * nrows) / nw);
    auto segid = [&](int row) { return row < LROWS ? (row >> 6) : 512 + ((row - LROWS) >> 8); };
    auto loadmg = [&](int row, float* m, float* g2) {
      if (row < 0 || row >= MROWS) {
#pragma unroll
        for (int e = 0; e < 8; ++e) { m[e] = 0.f; g2[e] = 0.f; }
      } else {
        const bf16_t* pr = PA + (size_t)row * 1024 + lane * 16;
        const uint4 u0 = *(const uint4*)pr, u1 = *(const uint4*)(pr + 8);
        m[0] = bflo(u0.x); g2[0] = bfhi(u0.x); m[1] = bflo(u0.y); g2[1] = bfhi(u0.y); m[2] = bflo(u0.z); g2[2] = bfhi(u0.z); m[3] = bflo(u0.w); g2[3] = bfhi(u0.w);
        m[4] = bflo(u1.x); g2[4] = bfhi(u1.x); m[5] = bflo(u1.y); g2[5] = bfhi(u1.y); m[6] = bflo(u1.z); g2[6] = bfhi(u1.z); m[7] = bflo(u1.w); g2[7] = bfhi(u1.w);
      }
    };
    float mp[8], mc[8], mn[8], gc[8], gn2[8], gdum[8];
    loadmg(R0 - 1, mp, gdum); loadmg(R0, mc, gc);
#pragma unroll 1
    for (int row = R0; row < R1; ++row) {
      loadmg(row + 1, mn, gn2);
      const int sg = segid(row);
      const bool okp = row > 0 && segid(row - 1) == sg, okn = segid(row + 1) == sg;
      float zb[8], of[8], ob[8], ya[8], yb[8];
      unpack8(*(const uint4*)(p.PZB + (size_t)row * 512 + lane * 8), zb);
      unpack8(*(const uint4*)(Of + (size_t)row * 512 + lane * 8), of);
      unpack8(*(const uint4*)(Ob + (size_t)row * 512 + lane * 8), ob);
      float ss = 0.f;
#pragma unroll
      for (int e = 0; e < 8; ++e) {
        float cv = cw[0][e] * (okp ? mp[e] : 0.f) + cw[1][e] * mc[e] + cw[2][e] * (okn ? mn[e] : 0.f);
        ya[e] = gc[e] * cv;
        of[e] += ob[e]; ss += of[e] * of[e];
      }
      ss += __shfl_xor(ss, 1); ss += __shfl_xor(ss, 2); ss += __shfl_xor(ss, 4); ss += __shfl_xor(ss, 8);
      const float rs = rsqrtf(ss * (1.f / 128.f) + 1e-6f);
#pragma unroll
      for (int e = 0; e < 8; ++e) yb[e] = of[e] * rs * gn[e] * silu_f(zb[e]);
      *(uint4*)(p.H + kb_off(row, lane * 8)) = pack8(ya);
      *(uint4*)(p.H + kb_off(row, 512 + lane * 8)) = pack8(yb);
#pragma unroll
      for (int e = 0; e < 8; ++e) { mp[e] = mc[e]; mc[e] = mn[e]; gc[e] = gn2[e]; }
    }
  }
}

__device__ void phase_final(const Params& p, int bid, int nblk) {
  int tid = threadIdx.x; asm volatile("" : "+v"(tid));
  const int lane = tid & 63, w = tid >> 6;
  float4 fnv[4];
#pragma unroll
  for (int i = 0; i < 4; ++i) fnv[i] = *(const float4*)(p.final_norm + i * 256 + lane * 4);
  for (int row = bid * 4 + w; row < LROWS; row += nblk * 4) {
    float* src = p.out + (size_t)row * 1024;
    float4 v[4]; float ss = 0.f;
#pragma unroll
    for (int i = 0; i < 4; ++i) {
      v[i] = *(const float4*)(src + i * 256 + lane * 4);
      ss += v[i].x * v[i].x + v[i].y * v[i].y + v[i].z * v[i].z + v[i].w * v[i].w;
    }
#pragma unroll
    for (int o = 32; o >= 1; o >>= 1) ss += __shfl_xor(ss, o);
    const float rstd = rsqrtf(ss * (1.f / 1024.f) + 1e-6f);
#pragma unroll
    for (int i = 0; i < 4; ++i) {
      const int cidx = i * 256 + lane * 4;
      const float4 nv = fnv[i];
      float4 o; o.x = v[i].x * rstd * nv.x; o.y = v[i].y * rstd * nv.y; o.z = v[i].z * rstd * nv.z; o.w = v[i].w * rstd * nv.w;
      *(float4*)(src + cidx) = o;
    }
  }
}


#define XB_TMO      128
#define XB_XCNT(j)  (256  + 64 * (j))
#define XB_XSUB(j)  (1280 + 64 * (j))
#define XB_XGEN(j)  (2304 + 64 * (j))
#define XB_TOP      3328
#define XB_TOPGEN   3392
#define XCD_BAR_WORDS 3456
#define XB_SPIN_CAP (1u << 18)
#define LAS __attribute__((address_space(3)))
__device__ __forceinline__ unsigned xb_ld(unsigned* p)              { return __hip_atomic_load(p, __ATOMIC_RELAXED, __HIP_MEMORY_SCOPE_AGENT); }
__device__ __forceinline__ unsigned xb_add(unsigned* p, unsigned v) { return __hip_atomic_fetch_add(p, v, __ATOMIC_RELAXED, __HIP_MEMORY_SCOPE_AGENT); }
__device__ __forceinline__ unsigned xb_xcc_id() { return (unsigned)__builtin_amdgcn_s_getreg((3 << 11) | 20) & 0xFu; }
#define XB_SPIN(cond, bar) do { unsigned _sp = 0; while (cond) { __builtin_amdgcn_s_sleep(1); \
    if ((++_sp & 255u) == 0u) { if (xb_ld(&(bar)[XB_TMO])) break; if (_sp > XB_SPIN_CAP) { atomicAdd(&(bar)[XB_TMO], 1u); break; } } } } while (0)
struct XcdBarrier { unsigned* bar; unsigned x; volatile LAS unsigned* st; };
__device__ __forceinline__ XcdBarrier xcd_barrier_post(unsigned* bar, volatile LAS unsigned* st) {
    XcdBarrier b; b.bar = bar; b.x = xb_xcc_id(); b.st = st;
    if (threadIdx.x == 0) (void)xb_add(&bar[XB_XCNT(b.x)], 1u);
    return b;
}
__device__ __forceinline__ void xcd_barrier_complete(unsigned* bar, unsigned x, unsigned& nloc, unsigned& nx) {
    const unsigned G = gridDim.x * gridDim.y * gridDim.z;
    unsigned sum, cnt, mine, sp = 0u;
    for (;;) {
        sum = 0u; cnt = 0u; mine = 0u;
#pragma unroll
        for (unsigned j = 0; j < 16; ++j) { const unsigned c = xb_ld(&bar[XB_XCNT(j)]); sum += c; cnt += (c > 0u) ? 1u : 0u; mine = (j == x) ? c : mine; }
        if (sum == G) break;
        __builtin_amdgcn_s_sleep(1);
        if ((++sp & 255u) == 0u) { if (xb_ld(&bar[XB_TMO])) break; if (sp > XB_SPIN_CAP) { atomicAdd(&bar[XB_TMO], 1u); break; } }
    }
    nloc = mine > 0u ? mine : 1u; nx = cnt > 0u ? cnt : 1u;
}
__device__ __forceinline__ void xcd_barrier(const XcdBarrier& b) {
    asm volatile("s_waitcnt vmcnt(0)" ::: "memory");
    __syncthreads();
    if (threadIdx.x == 0) {
        unsigned* bar = b.bar;
        __builtin_amdgcn_s_waitcnt(0);
        unsigned nloc = b.st[0], nx = b.st[1];
        if (nloc == 0u) { xcd_barrier_complete(bar, b.x, nloc, nx); b.st[0] = nloc; b.st[1] = nx; }
        const unsigned old = xb_add(&bar[XB_XSUB(b.x)], 1u);
        const unsigned gen = old / nloc;
        if (old + 1u == (gen + 1u) * nloc) {
            __builtin_amdgcn_fence(__ATOMIC_RELEASE, "agent");
            asm volatile("s_waitcnt vmcnt(0)" ::: "memory");
            const unsigned og = xb_add(&bar[XB_TOP], 1u);
            const unsigned tg = og / nx;
            if (og + 1u == (tg + 1u) * nx) xb_add(&bar[XB_TOPGEN], 1u);
            else XB_SPIN(xb_ld(&bar[XB_TOPGEN]) == tg, bar);
            __builtin_amdgcn_fence(__ATOMIC_ACQUIRE, "agent");
            xb_add(&bar[XB_XGEN(b.x)], 1u);
            asm volatile("s_waitcnt vmcnt(0)" ::: "memory");
        } else {
            XB_SPIN(xb_ld(&bar[XB_XGEN(b.x)]) == gen, bar);
            __builtin_amdgcn_fence(__ATOMIC_ACQUIRE, "agent");
            asm volatile("s_waitcnt vmcnt(0)" ::: "memory");
        }
    }
    __syncthreads();
}

#if N_LAUNCH_MODE == 1
__device__ __forceinline__ void run_phase(const Params& p, int ph, char* smem, int bid, int nblk) {
  if (ph == 0) { phase_mod(p, smem, bid, nblk); __syncthreads(); conv_weights(p, 0, smem, bid, nblk); return; }
  if (ph == NPHASE - 1) { phase_final(p, bid, nblk); return; }
  const int l = (ph - 1) / 7;
#ifdef ONLY_S
  const int s = ONLY_S;
#else
  const int s = (ph - 1) % 7;
#endif
#ifndef PMASK
#define PMASK 127
#endif
#ifdef DUP_S
  if (s == DUP_S) {
    if (s == 0) phase_prep(p, l, smem, bid, nblk);
    else if (s == 1) phase_gemm<0>(p, l, smem, bid, nblk);
    else if (s == 2) phase_pre(p, l, smem, bid, nblk);
    else if (s == 3) phase_scan(p, l, smem, bid, nblk);
    else if (s == 4) phase_gemm<1>(p, l, smem, bid, nblk);
    else if (s == 5) phase_y(p, l, bid, nblk);
    __syncthreads();
  }
#endif
  if ((PMASK & 1) && s == 0) { if (nblk <= 256 && l > 0) conv_weights(p, l, smem, bid, nblk);
    phase_prep(p, l, smem, bid, nblk); }
  else if ((PMASK & 2) && s == 1) phase_gemm<0>(p, l, smem, bid, nblk);
  else if ((PMASK & 4) && s == 2) phase_pre(p, l, smem, bid, nblk);
  else if ((PMASK & 8) && s == 3) {
    if (bid >= 256 && l < 3) conv_weights(p, l + 1, smem, bid - 256, nblk - 256);
    else phase_scan(p, l, smem, bid, nblk);
  }
  else if ((PMASK & 16) && s == 4) phase_gemm<1>(p, l, smem, bid, nblk);
  else if ((PMASK & 32) && s == 5) phase_y(p, l, bid, nblk);
  else if ((PMASK & 64) && s == 6) phase_gemm<2>(p, l, smem, bid, nblk);
}

#endif
#if N_LAUNCH_MODE == 1
__global__ void __launch_bounds__(256, 2) fwd_kernel(Params p) {
  extern __shared__ __attribute__((aligned(16))) char smem[];
  const int bid = blockIdx.x, nblk = gridDim.x;
  volatile LAS unsigned* st = (volatile LAS unsigned*)(smem + LDS_BYTES);
  if (threadIdx.x == 0) { st[0] = 0u; st[1] = 0u; st[2] = 0u; st[3] = 0u; }
  __syncthreads();
  (void)xcd_barrier_post(p.bar, st);
  for (int ph = p.phase_lo; ph < p.phase_hi; ++ph) {
    run_phase(p, ph, smem, bid, nblk);
    if (ph + 1 < p.phase_hi) {
      if (ph == 0) cg::this_grid().sync();
      else {
        XcdBarrier xb; xb.bar = p.bar; xb.x = xb_xcc_id(); xb.st = (volatile LAS unsigned*)((char*)smem + LDS_BYTES);
        xcd_barrier(xb);
      }
    }
  }
}
#else
template <int S>
__global__ void __launch_bounds__(256, 2) phase_kernel(Params p, int l) {
  extern __shared__ __attribute__((aligned(16))) char smem[];
  const int bid = blockIdx.x, nblk = gridDim.x;
  if (S == 7) phase_mod(p, smem, bid, nblk);
  else if (S == 8) phase_final(p, bid, nblk);
  else if (S == 0) phase_prep(p, l, smem, bid, nblk);
  else if (S == 1) phase_gemm<0>(p, l, smem, bid, nblk);
  else if (S == 2) phase_pre(p, l, smem, bid, nblk);
  else if (S == 3) phase_scan(p, l, smem, bid, nblk);
  else if (S == 4) phase_gemm<1>(p, l, smem, bid, nblk);
  else if (S == 5) phase_y(p, l, bid, nblk);
  else if (S == 6) phase_gemm<2>(p, l, smem, bid, nblk);
}
template <int S> static void launch_phase(const Params& p, int l, int grid, hipStream_t stream) {
  static bool init = false;
  if (!init) { (void)hipFuncSetAttribute((const void*)phase_kernel<S>, hipFuncAttributeMaxDynamicSharedMemorySize, LDS_BYTES); init = true; }
  hipLaunchKernelGGL(phase_kernel<S>, dim3(grid), dim3(256), LDS_BYTES, stream, p, l);
}
#endif

extern "C" void kernel_launch(void* const* d_in, const int* in_sizes, int n_in, void* d_out, int out_size, void* d_ws, size_t ws_size, hipStream_t stream) {
  static int grid = 0;
  if (grid == 0) {
    int dev = 0, cus = 0, per_cu = 0;
    (void)hipGetDevice(&dev);
    (void)hipDeviceGetAttribute(&cus, hipDeviceAttributeMultiprocessorCount, dev);
#if N_LAUNCH_MODE == 1
    (void)hipFuncSetAttribute((const void*)fwd_kernel, hipFuncAttributeMaxDynamicSharedMemorySize, LDS_BYTES + 16);
    (void)hipOccupancyMaxActiveBlocksPerMultiprocessor(&per_cu, (const void*)fwd_kernel, 256, LDS_BYTES + 16);
    if (per_cu < 1) per_cu = 1;
    if (per_cu > 2) per_cu = 2;
#else
    per_cu = 2;
#endif
    if (cus <= 0) cus = 256;
    grid = cus * per_cu;
    (void)hipGetLastError();
  }
  Params p{};
  p.x = (const float*)d_in[0]; p.c = (const float*)d_in[1]; p.ctx = (const float*)d_in[2]; p.c_ctx = (const float*)d_in[3];
  p.norm_w = (const float*)d_in[4]; p.w_mod = (const float*)d_in[5]; p.b_mod = (const float*)d_in[6]; p.w_in = (const float*)d_in[7];
  p.conv_a = (const float*)d_in[8]; p.conv_qkv = (const float*)d_in[9]; p.a_log = (const float*)d_in[10]; p.dt_bias = (const float*)d_in[11];
  p.gdn_norm = (const float*)d_in[12]; p.w_out = (const float*)d_in[13]; p.final_norm = (const float*)d_in[14];
  p.out = (float*)d_out;
  char* ws = (char*)d_ws; size_t off = 0;
  auto take = [&](size_t bytes) { char* r = ws + off; off += (bytes + 255) & ~(size_t)255; return r; };
  p.bar = (unsigned*)take((size_t)XCD_BAR_WORDS * 4);
  p.XC = (float*)take((size_t)2048 * 1024 * 4);
  p.MOD = (float*)take((size_t)4 * 9 * 3072 * 4);
  p.BA = (float*)take((size_t)MROWS * 16 * 4);
  p.SC = (float*)take((size_t)NTASK_C * 2 * 192 * 4);
  p.WtIn = (bf16_t*)take((size_t)2 * NPADW * 1024 * 2);
  p.WtOut = (bf16_t*)take((size_t)2 * 1024 * 1024 * 2);
  p.H = (bf16_t*)take((size_t)MROWS * 1024 * 2);
  p.PQKV = (bf16_t*)take((size_t)MROWS * 1536 * 2);
  p.PZB = (bf16_t*)take((size_t)MROWS * 512 * 2);
  p.PRE = (bf16_t*)take((size_t)NTASK_C * PRE_TASK * 2);
  if (off > ws_size) { fprintf(stderr, "workspace too small: need %zu have %zu\n", off, ws_size); return; }
#if N_LAUNCH_MODE == 1
  p.phase_lo = 0; p.phase_hi = NPHASE;
  (void)hipMemsetAsync(p.bar, 0, (size_t)XCD_BAR_WORDS * 4, stream);
  void* args[] = {&p};
  hipError_t e = hipLaunchCooperativeKernel((const void*)fwd_kernel, dim3(grid), dim3(256), args, LDS_BYTES + 16, stream);
  if (e != hipSuccess) fprintf(stderr, "cooperative launch failed: %s (grid %d)\n", hipGetErrorString(e), grid);
#else
  p.phase_lo = 0; p.phase_hi = 0;
  launch_phase<7>(p, 0, grid, stream);
  for (int l = 0; l < 4; ++l) {
    launch_phase<0>(p, l, grid, stream);
    launch_phase<1>(p, l, grid, stream);
    launch_phase<2>(p, l, grid, stream);
    launch_phase<3>(p, l, grid, stream);
    launch_phase<4>(p, l, grid, stream);
    launch_phase<5>(p, l, grid, stream);
    launch_phase<6>(p, l, grid, stream);
  }
  launch_phase<8>(p, 0, grid, stream);
#endif
}
```

```cpp
#include <hip/hip_runtime.h>
#include <hip/hip_cooperative_groups.h>
#include <cstdio>
namespace cg = cooperative_groups;

#ifndef N_LAUNCH_MODE
#define N_LAUNCH_MODE 1
#endif

typedef unsigned short bf16_t;
typedef short bf16x8 __attribute__((ext_vector_type(8)));
typedef float f32x4 __attribute__((ext_vector_type(4)));
typedef unsigned u32x4 __attribute__((ext_vector_type(4)));
typedef unsigned u32x2 __attribute__((ext_vector_type(2)));

constexpr int LROWS = 8 * 4096;
constexpr int MROWS = LROWS + 8 * 256;
constexpr int DPROJ = 4112;
constexpr int NPADW = 4224;
constexpr int PRE_TASK = 57344;
constexpr int NTASK_C = 8 * 4 * 68;
constexpr int LDS_BYTES = 73728;
constexpr int NPHASE = 30;

struct Params {
  const float *x, *c, *ctx, *c_ctx, *norm_w, *w_mod, *b_mod, *w_in, *conv_a, *conv_qkv, *a_log, *dt_bias, *gdn_norm, *w_out, *final_norm;
  float *out, *XC, *MOD, *BA, *SC;
  bf16_t *WtIn, *WtOut, *H, *PQKV, *PZB, *PRE;
  unsigned* bar;
  int phase_lo, phase_hi;
};

__device__ __forceinline__ float bf2f(bf16_t u) { return __uint_as_float(((unsigned)u) << 16); }
typedef __bf16 bf16x2_t __attribute__((ext_vector_type(2)));
typedef float f32x2_t __attribute__((ext_vector_type(2)));
__device__ __forceinline__ unsigned pack2(float lo, float hi) { f32x2_t v = {lo, hi}; bf16x2_t b = __builtin_convertvector(v, bf16x2_t); return __builtin_bit_cast(unsigned, b); }
__device__ __forceinline__ bf16_t f2bf(float f) { return (bf16_t)(pack2(f, 0.f) & 0xffffu); }
__device__ __forceinline__ float bflo(unsigned u) { return __uint_as_float(u << 16); }
__device__ __forceinline__ float bfhi(unsigned u) { return __uint_as_float(u & 0xffff0000u); }
__device__ __forceinline__ void unpack8(const uint4& u, float* f) {
  f[0] = bflo(u.x); f[1] = bfhi(u.x); f[2] = bflo(u.y); f[3] = bfhi(u.y);
  f[4] = bflo(u.z); f[5] = bfhi(u.z); f[6] = bflo(u.w); f[7] = bfhi(u.w);
}
__device__ __forceinline__ uint4 pack8(const float* f) {
  uint4 u; u.x = pack2(f[0], f[1]); u.y = pack2(f[2], f[3]); u.z = pack2(f[4], f[5]); u.w = pack2(f[6], f[7]); return u;
}
__device__ __forceinline__ float silu_f(float v) { return v * __builtin_amdgcn_rcpf(1.f + __expf(-v)); }
__device__ __forceinline__ f32x4 mfma16(bf16x8 a, bf16x8 b, f32x4 c) { return __builtin_amdgcn_mfma_f32_16x16x32_bf16(a, b, c, 0, 0, 0); }


__device__ __forceinline__ size_t kb_off(int row, int k8) {
  const int r = row & 127, c = (k8 >> 3) & 3;
  return (size_t)((row >> 7) * 32 + (k8 >> 5)) * 4096 + (r >> 2) * 128 + (r & 3) * 32 + ((c ^ ((r >> 2) & 3)) * 8);
}

__device__ void phase_mod(const Params& p, char* smem, int bid, int nblk) {
  float* s = (float*)smem;
  float* part = s + 9 * 1024;
  int tid = threadIdx.x; asm volatile("" : "+v"(tid));
  const int w = tid >> 6, lane = tid & 63;
  if (bid >= 192) return;
  for (int i = tid; i < 9 * 1024; i += 256) {
    int r = i >> 10, k = i & 1023;
    float v = r < 8 ? p.c[r * 1024 + k] : p.c_ctx[k];
    s[i] = silu_f(v);
  }
  __syncthreads();
  for (int t = bid; t < 192; t += nblk) {
    const int l = t / 48, j0 = (t % 48) * 64;
    const float* W = p.w_mod + (size_t)l * 1024 * 3072 + j0 + lane;
    float acc[9];
#pragma unroll
    for (int r = 0; r < 9; ++r) acc[r] = 0.f;
#pragma unroll 32
    for (int k = w * 256; k < w * 256 + 256; ++k) {
      float wv = W[(size_t)k * 3072];
#pragma unroll
      for (int r = 0; r < 9; ++r) acc[r] += s[r * 1024 + k] * wv;
    }
#pragma unroll
    for (int r = 0; r < 9; ++r) part[(w * 9 + r) * 64 + lane] = acc[r];
    __syncthreads();
    for (int i = tid; i < 576; i += 256) {
      int r = i >> 6, jj = i & 63;
      float v = part[(0 * 9 + r) * 64 + jj] + part[(1 * 9 + r) * 64 + jj] + part[(2 * 9 + r) * 64 + jj] + part[(3 * 9 + r) * 64 + jj];
      p.MOD[(size_t)(l * 9 + r) * 3072 + j0 + jj] = v + p.b_mod[l * 3072 + j0 + jj];
    }
    __syncthreads();
  }
}

__device__ void conv_weights(const Params& p, int l, char* smem, int bid, int nblk) {
  float* tile = (float*)smem;
  int tid = threadIdx.x; asm volatile("" : "+v"(tid));
  const int w = tid >> 6, lane = tid & 63;
  bf16_t* WtInL = p.WtIn + (size_t)(l & 1) * NPADW * 1024;
  bf16_t* WtOutL = p.WtOut + (size_t)(l & 1) * 1024 * 1024;
  {
    const float* srcp = p.w_in + (size_t)l * 1024 * DPROJ;
    for (int t = bid; t < 1056; t += nblk) {
      const int n0 = (t >> 4) * 64, k0 = (t & 15) * 64;
      for (int i = w; i < 64; i += 4) { int n = n0 + lane; tile[i * 65 + lane] = n < DPROJ ? srcp[(size_t)(k0 + i) * DPROJ + n] : 0.f; }
      __syncthreads();
      for (int i = w; i < 64; i += 4) {
        int n = n0 + i;
        if (n < 2048) {
          const int ssrc = n >> 9, ch = n & 511, jj = (ssrc == 1) ? 2 : (ssrc == 2 ? 1 : ssrc);
          n = (ch >> 5) * 128 + ((ch >> 4) & 1) * 64 + (ch & 3) * 16 + ((ch >> 2) & 3) * 4 + jj;
        } else {
          const int c = (n - 2048) & 127, base = (n - 2048) & ~127;
          n = 2048 + base + (c >> 6) * 64 + ((c >> 2) & 3) * 16 + ((c >> 4) & 3) * 4 + (c & 3);
        }
        WtInL[kb_off(n, (k0 + lane) & ~7) + (lane & 7)] = f2bf(tile[lane * 65 + i]);
      }
      __syncthreads();
    }
  }
  {
    const float* srcp = p.w_out + (size_t)l * 1024 * 1024;
    for (int t = bid + ((1056 - bid + nblk - 1) / nblk) * nblk - 1056; t < 256; t += nblk) {
      const int n0 = (t >> 4) * 64, k0 = (t & 15) * 64;
      for (int i = w; i < 64; i += 4) tile[i * 65 + lane] = srcp[(size_t)(k0 + i) * 1024 + n0 + lane];
      __syncthreads();
      for (int i = w; i < 64; i += 4) WtOutL[kb_off(n0 + i, (k0 + lane) & ~7) + (lane & 7)] = f2bf(tile[lane * 65 + i]);
      __syncthreads();
    }
  }
}

__device__ void phase_prep(const Params& p, int l, char* smem, int bid, int nblk) {
  int tid = threadIdx.x; asm volatile("" : "+v"(tid));
  const int w = tid >> 6, lane = tid & 63;
  const int gw = bid * 4 + w, nw = nblk * 4;
  const float* nwp = p.norm_w + l * 1024;
  const int R0 = (int)(((long)gw * MROWS) / nw), R1 = (int)(((long)(gw + 1) * MROWS) / nw);
  float4 am[4], sh[4];
  int bcur = -1;
  for (int row = R0; row < R1; ++row) {
    const float* src; int b, dstrow;
    if (row < LROWS) {
      b = row >> 12; int t = row & 4095;
      src = (l == 0 ? p.x : p.out) + (size_t)row * 1024;
      int ts = (l & 1) ? ((t & 63) * 64 + (t >> 6)) : t;
      dstrow = b * 4096 + ts;
    } else {
      b = 8; src = (l == 0 ? p.ctx : p.XC) + (size_t)(row - LROWS) * 1024; dstrow = row;
    }
    float4 v[4]; float ss = 0.f;
#pragma unroll
    for (int i = 0; i < 4; ++i) {
      v[i] = *(const float4*)(src + (i >> 1) * 512 + lane * 8 + (i & 1) * 4);
      ss += v[i].x * v[i].x + v[i].y * v[i].y + v[i].z * v[i].z + v[i].w * v[i].w;
    }
    if (b != bcur) {
      bcur = b;
      const float* md = p.MOD + (size_t)(l * 9 + b) * 3072;
#pragma unroll
      for (int i = 0; i < 4; ++i) {
        const int cidx = (i >> 1) * 512 + lane * 8 + (i & 1) * 4;
        const float4 nv = *(const float4*)(nwp + cidx), sc = *(const float4*)(md + 1024 + cidx);
        sh[i] = *(const float4*)(md + cidx);
        am[i].x = nv.x * (1.f + sc.x); am[i].y = nv.y * (1.f + sc.y); am[i].z = nv.z * (1.f + sc.z); am[i].w = nv.w * (1.f + sc.w);
      }
    }
#pragma unroll
    for (int o = 32; o >= 1; o >>= 1) ss += __shfl_xor(ss, o);
    const float rstd = rsqrtf(ss * (1.f / 1024.f) + 1e-6f);
#pragma unroll
    for (int j = 0; j < 2; ++j) {
      u32x4 o4;
#pragma unroll
      for (int hh = 0; hh < 2; ++hh) {
        const int i = 2 * j + hh;
        const float h0 = v[i].x * rstd * am[i].x + sh[i].x;
        const float h1 = v[i].y * rstd * am[i].y + sh[i].y;
        const float h2 = v[i].z * rstd * am[i].z + sh[i].z;
        const float h3 = v[i].w * rstd * am[i].w + sh[i].w;
        o4[2 * hh] = pack2(h0, h1); o4[2 * hh + 1] = pack2(h2, h3);
      }
      *(u32x4*)(p.H + kb_off(dstrow, j * 512 + lane * 8)) = o4;
    }
  }
}

template <int MODE>
__device__ void phase_gemm(const Params& p, int l, char* smem, int bid, int nblk) {
  constexpr int NT = MODE == 0 ? 17 : (MODE == 1 ? 16 : 8);
  const int MT = (l == 3 && MODE != 0) ? 256 : 272;
  const bf16_t* A = p.H;
  const bf16_t* WtInL = p.WtIn + (size_t)(l & 1) * NPADW * 1024;
  const bf16_t* Bt = MODE == 2 ? p.WtOut + (size_t)(l & 1) * 1024 * 1024 : WtInL;
  char* As = smem;
  char* Bs = smem + 49152;
  int tid = threadIdx.x; asm volatile("" : "+v"(tid));
  const int lane = tid & 63, w = __builtin_amdgcn_readfirstlane(tid >> 6), wr = w >> 1, wc = w & 1, i16 = lane & 15, q4 = lane >> 4;
  const int fbase = (i16 >> 2) * 256 + (i16 & 3) * 64 + ((q4 ^ (i16 >> 2)) * 16);
  const int xcd = bid & 7, jb = bid >> 3, nb8 = nblk >> 3;
  if (jb >= nb8) return;
  const bool use_small = (MODE == 2) && (MT == 272);
  const int nbig = (use_small ? 16 : (MT >> 4)) * NT;
  const int nloc = nbig + (use_small ? 2 * NT : 0);
  const int bpanel0 = MODE == 0 ? 16 : 0;
  for (int tq = jb; tq < nloc; tq += nb8) {
    f32x4 acc[8][4];
#pragma unroll
    for (int i = 0; i < 8; ++i)
#pragma unroll
      for (int j = 0; j < 4; ++j) acc[i][j] = (f32x4){0.f, 0.f, 0.f, 0.f};
    if (MODE == 2 && tq >= nbig) {
      const int s_ = tq - nbig;
      const int panel = (16 * 8 + xcd) * 2 + s_ / NT, nts = s_ % NT;
      const bf16_t* Ag = A + (size_t)panel * 32 * 4096 + tid * 8;
      const bf16_t* Bg = Bt + (size_t)(bpanel0 + nts) * 32 * 4096 + tid * 8;
#define DMA_S(KS, ST) do { _Pragma("unroll") for (int i = 0; i < 2; ++i) { \
        __builtin_amdgcn_global_load_lds((const unsigned*)(Ag + (size_t)(KS) * 4096 + i * 2048), (__attribute__((address_space(3))) unsigned*)(As + (ST) * 16384 + i * 4096 + tid * 16), 16, 0, 0); \
        __builtin_amdgcn_global_load_lds((const unsigned*)(Bg + (size_t)(KS) * 4096 + i * 2048), (__attribute__((address_space(3))) unsigned*)(Bs + (ST) * 8192 + i * 4096 + tid * 16), 16, 0, 0); } } while (0)
#define STEP_S(S, ST, STN) do { \
        asm volatile("s_waitcnt vmcnt(4)" ::: "memory"); \
        __builtin_amdgcn_s_barrier(); \
        asm volatile("" ::: "memory"); \
        { const int ks = (S) + 2 < 32 ? (S) + 2 : 31; DMA_S(ks, STN); } \
        { const char* Ab = As + (ST) * 16384 + fbase; const char* Bb = Bs + (ST) * 8192 + w * 2048 + fbase; \
          bf16x8 bfr[2]; \
          bfr[0] = *(const bf16x8*)(Bb); bfr[1] = *(const bf16x8*)(Bb + 1024); \
          _Pragma("unroll") for (int mh = 0; mh < 2; ++mh) { bf16x8 af[4]; \
            _Pragma("unroll") for (int mi = 0; mi < 4; ++mi) af[mi] = *(const bf16x8*)(Ab + (mh * 4 + mi) * 1024); \
            _Pragma("unroll") for (int mi = 0; mi < 4; ++mi) { acc[mh * 4 + mi][0] = mfma16(bfr[0], af[mi], acc[mh * 4 + mi][0]); acc[mh * 4 + mi][1] = mfma16(bfr[1], af[mi], acc[mh * 4 + mi][1]); } \
            __builtin_amdgcn_sched_barrier(0); } } } while (0)
      DMA_S(0, 0); DMA_S(1, 1);
#pragma unroll 1
      for (int s3 = 0; s3 < 30; s3 += 3) { STEP_S(s3, 0, 2); STEP_S(s3 + 1, 1, 0); STEP_S(s3 + 2, 2, 1); }
      STEP_S(30, 0, 2); STEP_S(31, 1, 0);
      asm volatile("s_waitcnt vmcnt(0)" ::: "memory");
      __builtin_amdgcn_s_barrier();
      asm volatile("" ::: "memory");
#undef DMA_S
#undef STEP_S
#pragma unroll
      for (int mi = 0; mi < 8; ++mi) {
        const int row = panel * 128 + mi * 16 + i16;
        if (MODE == 2) {
          const float* srcp; float* dstp; int b;
          if (row < LROWS) {
            b = row >> 12; int ts = row & 4095;
            int tt = (l & 1) ? ((ts & 63) * 64 + (ts >> 6)) : ts;
            size_t off = (size_t)(b * 4096 + tt) * 1024;
            srcp = (l == 0 ? p.x : p.out) + off; dstp = p.out + off;
          } else {
            b = 8; size_t off = (size_t)(row - LROWS) * 1024;
            srcp = (l == 0 ? p.ctx : p.XC) + off; dstp = p.XC + off;
          }
          const float* gate = p.MOD + (size_t)(l * 9 + b) * 3072 + 2048;
#pragma unroll
          for (int ni = 0; ni < 2; ++ni) {
            const int n = nts * 128 + w * 32 + ni * 16 + q4 * 4;
            float4 xv = *(const float4*)(srcp + n), gv = *(const float4*)(gate + n);
            float4 o; o.x = xv.x + gv.x * acc[mi][ni][0]; o.y = xv.y + gv.y * acc[mi][ni][1]; o.z = xv.z + gv.z * acc[mi][ni][2]; o.w = xv.w + gv.w * acc[mi][ni][3];
            *(float4*)(dstp + n) = o;
          }
        } else if (MODE == 1) {
          u32x2 o2;
          o2[0] = pack2(acc[mi][0][0] * acc[mi][0][1], acc[mi][0][2] * silu_f(acc[mi][0][3]));
          o2[1] = pack2(acc[mi][1][0] * acc[mi][1][1], acc[mi][1][2] * silu_f(acc[mi][1][3]));
          *(u32x2*)(p.PRE + (size_t)row * 1024 + (nts * 32 + (w >> 1) * 16 + q4 * 4 + (w & 1) * 2) * 2) = o2;
        }
      }
      continue;
    }
    const int mt2 = (tq / NT) * 8 + xcd, nt = tq % NT;
    const bf16_t* Ag = A + (size_t)(mt2 * 2) * 32 * 4096 + tid * 8;
    const bf16_t* Bg = Bt + (size_t)(bpanel0 + nt) * 32 * 4096 + tid * 8;
#define DMA_STEP(KS, ST) do { _Pragma("unroll") for (int i = 0; i < 2; ++i) { \
      __builtin_amdgcn_global_load_lds((const unsigned*)(Ag + (size_t)(KS) * 4096 + i * 2048), (__attribute__((address_space(3))) unsigned*)(As + (ST) * 16384 + i * 4096 + tid * 16), 16, 0, 0); \
      __builtin_amdgcn_global_load_lds((const unsigned*)(Ag + (size_t)(32 + (KS)) * 4096 + i * 2048), (__attribute__((address_space(3))) unsigned*)(As + (ST) * 16384 + 8192 + i * 4096 + tid * 16), 16, 0, 0); \
      __builtin_amdgcn_global_load_lds((const unsigned*)(Bg + (size_t)(KS) * 4096 + i * 2048), (__attribute__((address_space(3))) unsigned*)(Bs + (ST) * 8192 + i * 4096 + tid * 16), 16, 0, 0); } } while (0)
#define COMPUTE(ST) do { const char* Ab = As + (ST) * 16384 + wr * 8192 + fbase; const char* Bb = Bs + (ST) * 8192 + wc * 4096 + fbase; \
      bf16x8 af[8], bfr[4]; \
      _Pragma("unroll") for (int mi = 0; mi < 8; ++mi) af[mi] = *(const bf16x8*)(Ab + mi * 1024); \
      _Pragma("unroll") for (int ni = 0; ni < 4; ++ni) bfr[ni] = *(const bf16x8*)(Bb + ni * 1024); \
      __builtin_amdgcn_s_setprio(1); \
      _Pragma("unroll") for (int mi = 0; mi < 8; ++mi) _Pragma("unroll") for (int ni = 0; ni < 4; ++ni) acc[mi][ni] = mfma16(bfr[ni], af[mi], acc[mi][ni]); \
      __builtin_amdgcn_s_setprio(0); } while (0)
#define STEP(S, ST, STN) do { \
      asm volatile("s_waitcnt vmcnt(6)" ::: "memory");     \
      __builtin_amdgcn_s_barrier();                        \
      asm volatile("" ::: "memory"); \
      { const int ks = (S) + 2 < 32 ? (S) + 2 : 31; DMA_STEP(ks, STN); }     \
      COMPUTE(ST); } while (0)
    DMA_STEP(0, 0); DMA_STEP(1, 1);
#pragma unroll 1
    for (int s3 = 0; s3 < 30; s3 += 3) {
      STEP(s3, 0, 2); STEP(s3 + 1, 1, 0); STEP(s3 + 2, 2, 1);
    }
    STEP(30, 0, 2); STEP(31, 1, 0);
    asm volatile("s_waitcnt vmcnt(0)" ::: "memory");
    __builtin_amdgcn_s_barrier();
    asm volatile("" ::: "memory");
#undef DMA_STEP
#undef COMPUTE
#undef STEP
#pragma unroll
    for (int mi = 0; mi < 8; ++mi) {
      const int row = (mt2 * 2 + wr) * 128 + mi * 16 + i16;
      if (MODE == 2) {
        const float* srcp; float* dstp; int b;
        if (row < LROWS) {
          b = row >> 12; int ts = row & 4095;
          int tt = (l & 1) ? ((ts & 63) * 64 + (ts >> 6)) : ts;
          size_t off = (size_t)(b * 4096 + tt) * 1024;
          srcp = (l == 0 ? p.x : p.out) + off; dstp = p.out + off;
        } else {
          b = 8; size_t off = (size_t)(row - LROWS) * 1024;
          srcp = (l == 0 ? p.ctx : p.XC) + off; dstp = p.XC + off;
        }
        const float* gate = p.MOD + (size_t)(l * 9 + b) * 3072 + 2048;
#pragma unroll
        for (int ni = 0; ni < 4; ++ni) {
          const int n = nt * 128 + wc * 64 + ni * 16 + q4 * 4;
          float4 xv = *(const float4*)(srcp + n), gv = *(const float4*)(gate + n);
          float4 o; o.x = xv.x + gv.x * acc[mi][ni][0]; o.y = xv.y + gv.y * acc[mi][ni][1]; o.z = xv.z + gv.z * acc[mi][ni][2]; o.w = xv.w + gv.w * acc[mi][ni][3];
          *(float4*)(dstp + n) = o;
        }
      } else if (MODE == 1) {
        u32x4 o4;
#pragma unroll
        for (int ni = 0; ni < 4; ++ni) o4[ni] = pack2(acc[mi][ni][0] * acc[mi][ni][1], acc[mi][ni][2] * silu_f(acc[mi][ni][3]));
        *(u32x4*)(p.PRE + (size_t)row * 1024 + (nt * 32 + wc * 16 + q4 * 4) * 2) = o4;
      } else {
        const int n0 = nt * 128 + wc * 64 + q4 * 16;
        u32x4 lo, hi;
        lo[0] = pack2(acc[mi][0][0], acc[mi][0][1]); lo[1] = pack2(acc[mi][0][2], acc[mi][0][3]); lo[2] = pack2(acc[mi][1][0], acc[mi][1][1]); lo[3] = pack2(acc[mi][1][2], acc[mi][1][3]);
        hi[0] = pack2(acc[mi][2][0], acc[mi][2][1]); hi[1] = pack2(acc[mi][2][2], acc[mi][2][3]); hi[2] = pack2(acc[mi][3][0], acc[mi][3][1]); hi[3] = pack2(acc[mi][3][2], acc[mi][3][3]);
        if (n0 < 1536) {
          bf16_t* d = p.PQKV + (size_t)row * 1536 + n0;
          *(u32x4*)d = lo; *(u32x4*)(d + 8) = hi;
        } else if (n0 < 2048) {
          bf16_t* d = p.PZB + (size_t)row * 512 + (n0 - 1536);
          *(u32x4*)d = lo; *(u32x4*)(d + 8) = hi;
        } else if (n0 == 2048) {
          float* d = p.BA + (size_t)row * 16;
#pragma unroll
          for (int ni = 0; ni < 4; ++ni) *(f32x4*)(d + ni * 4) = acc[mi][ni];
        }
      }
    }
  }
}


__device__ __forceinline__ int fo_w(int r, int k8)  { return ((r >> 4) * 4 + (k8 >> 2)) * 64 + (k8 & 3) * 16 + (r & 15); }
__device__ __forceinline__ int fo_kT(int k, int t8) { return ((k >> 4) * 2 + (t8 >> 2)) * 64 + (t8 & 3) * 16 + (k & 15); }
__device__ __forceinline__ int fo_u0(int v, int r4) { return ((v >> 4) * 4 + (r4 >> 2)) * 64 + (r4 & 3) * 16 + (v & 15); }

__device__ void phase_pre(const Params& p, int l, char* smem, int bid, int nblk) {
  float* Am = (float*)smem;
  float* sbeta = Am + 64 * 64;
  float* sgc = sbeta + 128;
  float* sbk = sgc + 128;
  float* Tm = sbk + 128;
  bf16_t* qs = (bf16_t*)(Tm + 1024);
  bf16_t* ks = qs + 64 * 136;
  bf16_t* vs = ks + 64 * 136;
  int tid = threadIdx.x; asm volatile("" : "+v"(tid));
  const int lane = tid & 63, w = tid >> 6, i16 = lane & 15, q4 = lane >> 4;
  const float* cwp = p.conv_qkv + (size_t)l * 3 * 1536;
  for (int task = bid; task < NTASK_C; task += nblk) {
    const int b = task / 272, rem = task % 272, h = rem / 68, c = rem % 68;
    const int row0 = c < 64 ? b * 4096 + c * 64 : LROWS + b * 256 + (c - 64) * 64;
    const bool halo_lo = c > 64, halo_hi = (c >= 64 && c < 67);
    bf16_t* PREt = p.PRE + (size_t)task * PRE_TASK;
    {
      const int rg = tid >> 4, cgp = tid & 15;
      uint4 raw[3][6];
#define PRE_RAW_LOAD(MAT) do { _Pragma("unroll") for (int i = 0; i < 6; ++i) { \
          const int lr = rg * 4 - 1 + i; \
          const bool valid = (lr >= 0 || halo_lo) && (lr <= 63 || halo_hi); \
          raw[MAT][i] = make_uint4(0, 0, 0, 0); \
          if (valid) raw[MAT][i] = *(const uint4*)(p.PQKV + (size_t)(row0 + lr) * 1536 + (MAT) * 512 + h * 128 + cgp * 8); } } while (0)
      PRE_RAW_LOAD(0); PRE_RAW_LOAD(1);
      if (w < 2) {
        const int d = w;
        const int tok = d ? 63 - lane : lane;
        const float* ba = p.BA + (size_t)(row0 + tok) * 16;
        const float bl = ba[d * 4 + h], al = ba[8 + d * 4 + h];
        const float beta = 1.f / (1.f + __expf(-bl));
        const float xx = al + p.dt_bias[l * 8 + d * 4 + h];
        const float sp = fmaxf(xx, 0.f) + log1pf(__expf(-fabsf(xx)));
        float g = -__expf(p.a_log[l * 8 + d * 4 + h]) * sp;
#pragma unroll
        for (int o = 1; o < 64; o <<= 1) { float t = __shfl_up(g, o); if (lane >= o) g += t; }
        const float gl = __shfl(g, 63);
        const float eg = __expf(g);
        sbeta[d * 64 + lane] = beta; sgc[d * 64 + lane] = g; sbk[d * 64 + lane] = beta * eg;
        float* SCt = p.SC + (size_t)(task * 2 + d) * 192;
        SCt[lane] = eg; SCt[64 + lane] = __expf(gl - g);
        if (lane == 0) SCt[128] = __expf(gl);
      }
#pragma unroll
      for (int mat = 0; mat < 3; ++mat) {
        if (mat == 1) { PRE_RAW_LOAD(2); }
        const int colbase = mat * 512 + h * 128 + cgp * 8;
        float cw[3][8];
#pragma unroll
        for (int j = 0; j < 3; ++j) {
          float4 a = *(const float4*)(cwp + j * 1536 + colbase), bq = *(const float4*)(cwp + j * 1536 + colbase + 4);
          cw[j][0] = a.x; cw[j][1] = a.y; cw[j][2] = a.z; cw[j][3] = a.w; cw[j][4] = bq.x; cw[j][5] = bq.y; cw[j][6] = bq.z; cw[j][7] = bq.w;
        }
        float xr[6][8];
#pragma unroll
        for (int i = 0; i < 6; ++i) unpack8(raw[mat][i], xr[i]);
#pragma unroll
        for (int i = 0; i < 4; ++i) {
          float y[8]; float ss = 0.f;
#pragma unroll
          for (int e = 0; e < 8; ++e) {
            float t = cw[0][e] * xr[i][e] + cw[1][e] * xr[i + 1][e] + cw[2][e] * xr[i + 2][e];
            t = silu_f(t); y[e] = t; ss += t * t;
          }
          if (mat < 2) {
            ss += __shfl_xor(ss, 1); ss += __shfl_xor(ss, 2); ss += __shfl_xor(ss, 4); ss += __shfl_xor(ss, 8);
            float rs = rsqrtf(ss + 1e-6f) * (mat == 0 ? 0.08838834764831845f : 1.f);
#pragma unroll
            for (int e = 0; e < 8; ++e) y[e] *= rs;
          }
          const int r = rg * 4 + i;
          uint4 o = pack8(y);
          if (mat == 0) *(uint4*)(qs + r * 136 + cgp * 8) = o;
          else if (mat == 1) *(uint4*)(ks + r * 136 + cgp * 8) = o;
          else *(uint4*)(vs + r * 128 + cgp * 8) = o;
        }
        __builtin_amdgcn_sched_barrier(0);
      }
#undef PRE_RAW_LOAD
    }
    __syncthreads();
    {
#pragma unroll
      for (int i = 0; i < 4; ++i) {
        const int u = tid + i * 256;
        const int blk = u >> 6, qq = (u >> 4) & 3, ii = u & 15;
        const int row = (blk >> 2) * 16 + ii, cc = (blk & 3) * 4 + qq;
        *(uint4*)(PREt + u * 8) = *(const uint4*)(qs + row * 136 + cc * 8);
        const int kidx = (blk >> 1) * 16 + ii, tg = (blk & 1) * 4 + qq;
        float f[8];
#pragma unroll
        for (int e = 0; e < 8; ++e) f[e] = bf2f(ks[(tg * 8 + e) * 136 + kidx]);
        *(uint4*)(PREt + 8192 + u * 8) = pack8(f);
      }
    }
#pragma unroll 1
    for (int d = 0; d < 2; ++d) {
      bf16_t* dirb = PREt + 16384 + d * 20480;
      const float* sbeta_d = sbeta + d * 64; const float* sgc_d = sgc + d * 64; const float* sbk_d = sbk + d * 64;
      __syncthreads();
      {
        bf16x8 ktf[4], qtf[4];
#pragma unroll
        for (int kk = 0; kk < 4; ++kk) {
          ktf[kk] = *(const bf16x8*)(ks + (16 * w + i16) * 136 + kk * 32 + q4 * 8);
          qtf[kk] = *(const bf16x8*)(qs + (16 * w + i16) * 136 + kk * 32 + q4 * 8);
        }
        const int t = 16 * w + i16;
        const int r = d ? 63 - t : t;
        const float gr = sgc_d[r], br = sbeta_d[r];
#pragma unroll
        for (int st = 0; st < 4; ++st) {
          f32x4 kkr = (f32x4){0.f, 0.f, 0.f, 0.f}, qkr = (f32x4){0.f, 0.f, 0.f, 0.f};
#pragma unroll
          for (int kk = 0; kk < 4; ++kk) {
            bf16x8 ksf = *(const bf16x8*)(ks + (16 * st + i16) * 136 + kk * 32 + q4 * 8);
            kkr = mfma16(ksf, ktf[kk], kkr);
            qkr = mfma16(ksf, qtf[kk], qkr);
          }
          float pv[4];
#pragma unroll
          for (int jj = 0; jj < 4; ++jj) {
            const int s = 16 * st + 4 * q4 + jj;
            const int cd = d ? 63 - s : s;
            const float dec = __expf(fminf(gr - sgc_d[cd], 0.f));
            Am[r * 64 + cd] = (r > cd) ? br * kkr[jj] * dec : 0.f;
            pv[jj] = (r >= cd) ? qkr[jj] * dec : 0.f;
          }
          uint2 o2; o2.x = pack2(pv[0], pv[1]); o2.y = pack2(pv[2], pv[3]);
          *(uint2*)(dirb + 16384 + fo_kT(r, 2 * st + (q4 >> 1)) * 8 + (q4 & 1) * 4) = o2;
        }
      }
      __syncthreads();
      if (w == 0) {
        const int bi = lane >> 4, j = lane & 15;
        const float* Ab = Am + (16 * bi) * 64 + 16 * bi;
        float t[16];
#pragma unroll
        for (int r = 0; r < 16; ++r) {
          float a = (r == j) ? 1.f : 0.f;
#pragma unroll
          for (int c = 0; c < r; ++c) a -= Ab[r * 64 + c] * t[c];
          t[r] = a;
        }
#pragma unroll
        for (int r = 0; r < 16; ++r) Tm[(bi * 16 + r) * 16 + j] = t[r];
      }
      __syncthreads();
      {
        const bool isk = w >= 2;
        bf16x8 Aop[6], Top[4];
        {
          int pi = 0;
#pragma unroll
          for (int i = 1; i < 4; ++i)
#pragma unroll
            for (int j = 0; j < i; ++j) {
              const float4 a = *(const float4*)(Am + (16 * i + i16) * 64 + 16 * j + 4 * q4);
              u32x4 u; u[0] = pack2(-a.x, -a.y); u[1] = pack2(-a.z, -a.w); u[2] = 0u; u[3] = 0u;
              Aop[pi++] = __builtin_bit_cast(bf16x8, u);
            }
#pragma unroll
          for (int i = 0; i < 4; ++i) {
            const float4 t4 = *(const float4*)(Tm + (16 * i + i16) * 16 + 4 * q4);
            u32x4 u; u[0] = pack2(t4.x, t4.y); u[1] = pack2(t4.z, t4.w); u[2] = 0u; u[3] = 0u;
            Top[i] = __builtin_bit_cast(bf16x8, u);
          }
        }
        const float* sarr = isk ? sbk_d : sbeta_d;
        const int stride = isk ? 136 : 128;
        __syncthreads();
        bf16_t* wst = (bf16_t*)Am;
#pragma unroll 2
        for (int tt = 0; tt < 4; ++tt) {
          const int n = 64 * w + 16 * tt + i16;
          const bf16_t* sp = isk ? (ks + (n - 128)) : (vs + n);
          bf16x8 Xop[3];
#pragma unroll
          for (int i = 0; i < 4; ++i) {
            const float4 sv = *(const float4*)(sarr + 16 * i + 4 * q4);
            const int r0 = 16 * i + 4 * q4;
            f32x4 R;
            R[0] = bf2f(sp[(d ? 63 - r0 : r0) * stride]) * sv.x;
            R[1] = bf2f(sp[(d ? 62 - r0 : r0 + 1) * stride]) * sv.y;
            R[2] = bf2f(sp[(d ? 61 - r0 : r0 + 2) * stride]) * sv.z;
            R[3] = bf2f(sp[(d ? 60 - r0 : r0 + 3) * stride]) * sv.w;
#pragma unroll
            for (int j = 0; j < i; ++j) R = mfma16(Aop[i * (i - 1) / 2 + j], Xop[j], R);
            u32x4 ur; ur[0] = pack2(R[0], R[1]); ur[1] = pack2(R[2], R[3]); ur[2] = 0u; ur[3] = 0u;
            const f32x4 X = mfma16(Top[i], __builtin_bit_cast(bf16x8, ur), (f32x4){0.f, 0.f, 0.f, 0.f});
            u32x4 ux; ux[0] = pack2(X[0], X[1]); ux[1] = pack2(X[2], X[3]); ux[2] = 0u; ux[3] = 0u;
            if (i < 3) Xop[i] = __builtin_bit_cast(bf16x8, ux);
            if (!isk) {
              uint2 o2; o2.x = ux[0]; o2.y = ux[1];
              const int nl = (n & ~31) | (((n >> 2) & 1) * 16 + ((n >> 3) & 3) * 4 + (n & 3));
              *(uint2*)(dirb + 8192 + fo_u0(nl, r0 >> 2) * 4) = o2;
            } else {
              bf16_t* dst = wst + r0 * 128 + (n - 128);
              dst[0] = (bf16_t)(ux[0] & 0xffffu); dst[128] = (bf16_t)(ux[0] >> 16);
              dst[256] = (bf16_t)(ux[1] & 0xffffu); dst[384] = (bf16_t)(ux[1] >> 16);
            }
          }
        }
        __syncthreads();
#pragma unroll
        for (int i = 0; i < 4; ++i) {
          const int u = tid + i * 256;
          const int blk = u >> 6, qq = (u >> 4) & 3, ii = u & 15;
          const int row = (blk >> 2) * 16 + ii, cc = (blk & 3) * 4 + qq;
          *(uint4*)(dirb + u * 8) = *(const uint4*)(wst + row * 128 + cc * 8);
        }
      }
    }
    __syncthreads();
  }
}

struct ScanE { bf16x8 wf[4], qf[4]; uint2 u0[2]; float4 ed; float eg, egl; };
struct ScanL { bf16x8 pf[2], kTf[2][2]; };

__device__ __forceinline__ int scan_chunk(int n, int d) { return n < 4 ? 64 + (d ? 3 - n : n) : (d ? 63 - (n - 4) : n - 4); }

__device__ __forceinline__ void scan_load_e(const Params& p, ScanE& o, int n, int b, int h, int d, int slice, int w, int i16, int q4) {
  const int task = b * 272 + h * 68 + scan_chunk(n, d);
  const bf16_t* PREt = p.PRE + (size_t)task * PRE_TASK;
  const bf16_t* dirb = PREt + 16384 + d * 20480;
  const float* SCt = p.SC + (size_t)(task * 2 + d) * 192;
  const int r = 16 * w + i16;
  const int tok = d ? 63 - r : r;
#pragma unroll
  for (int kk = 0; kk < 4; ++kk) {
    o.wf[kk] = *(const bf16x8*)(dirb + fo_w(r, kk * 4 + q4) * 8);
    o.qf[kk] = *(const bf16x8*)(PREt + fo_w(tok, kk * 4 + q4) * 8);
  }
#pragma unroll
  for (int nt = 0; nt < 2; ++nt) o.u0[nt] = *(const uint2*)(dirb + 8192 + fo_u0(slice * 32 + 16 * nt + i16, 4 * w + q4) * 4);
  o.ed = *(const float4*)(SCt + 64 + 16 * w + 4 * q4);
  o.eg = SCt[r];
  o.egl = SCt[128];
}
__device__ __forceinline__ void scan_load_l(const Params& p, ScanL& o, int n, int b, int h, int d, int w, int i16, int q4) {
  const int task = b * 272 + h * 68 + scan_chunk(n, d);
  const bf16_t* PREt = p.PRE + (size_t)task * PRE_TASK;
  const bf16_t* dirb = PREt + 16384 + d * 20480;
  const int r = 16 * w + i16;
#pragma unroll
  for (int kk = 0; kk < 2; ++kk) {
    o.pf[kk] = *(const bf16x8*)(dirb + 16384 + fo_kT(r, kk * 4 + q4) * 8);
#pragma unroll
    for (int mt = 0; mt < 2; ++mt) o.kTf[mt][kk] = *(const bf16x8*)(PREt + 8192 + fo_kT(32 * w + 16 * mt + i16, kk * 4 + q4) * 8);
  }
}

__device__ void phase_scan(const Params& p, int l, char* smem, int bid, int nblk) {
  if (bid >= 256) return;
  bf16_t* S_lds = (bf16_t*)smem;
  bf16_t* U_lds = S_lds + 32 * 136;
  bf16_t* Ud_lds = U_lds + 32 * 72;
  int tid = threadIdx.x; asm volatile("" : "+v"(tid));
  const int lane = tid & 63, w = tid >> 6, i16 = lane & 15, q4 = lane >> 4;
  const int xcd = bid & 7, idx = bid >> 3;
  const int chain = xcd * 8 + (idx >> 2), slice = idx & 3;
  const int b = chain >> 3, h = (chain >> 1) & 3, d = chain & 1;
  bf16_t* Og = p.PQKV + (size_t)d * MROWS * 512;
  for (int i = tid; i < 32 * 136 / 2; i += 256) ((unsigned*)S_lds)[i] = 0u;
  f32x4 Sacc[2][2];
#pragma unroll
  for (int i = 0; i < 2; ++i)
#pragma unroll
    for (int j = 0; j < 2; ++j) Sacc[i][j] = (f32x4){0.f, 0.f, 0.f, 0.f};
  ScanE E0, E1; ScanL L0, L1;
  scan_load_e(p, E0, 0, b, h, d, slice, w, i16, q4);
  scan_load_l(p, L0, 0, b, h, d, w, i16, q4);
  scan_load_e(p, E1, 1, b, h, d, slice, w, i16, q4);
  scan_load_l(p, L1, 1, b, h, d, w, i16, q4);
  __syncthreads();
  auto scan_step = [&](const int n, ScanE& EC, ScanL& LC) __attribute__((always_inline)) {
    const int c = scan_chunk(n, d);
    const int row0 = c < 64 ? b * 4096 + c * 64 : LROWS + b * 256 + (c - 64) * 64;
    bf16x8 Sf[2][4];
#pragma unroll
    for (int nt = 0; nt < 2; ++nt)
#pragma unroll
      for (int kk = 0; kk < 4; ++kk) Sf[nt][kk] = *(const bf16x8*)(S_lds + (16 * nt + i16) * 136 + kk * 32 + q4 * 8);
    f32x4 accO[2];
    const float egl = EC.egl;
#pragma unroll
    for (int nt = 0; nt < 2; ++nt) {
      f32x4 accU = (f32x4){0.f, 0.f, 0.f, 0.f};
      accO[nt] = (f32x4){0.f, 0.f, 0.f, 0.f};
#pragma unroll
      for (int kk = 0; kk < 4; ++kk) {
        accU = mfma16(EC.wf[kk], Sf[nt][kk], accU);
        accO[nt] = mfma16(Sf[nt][kk], EC.qf[kk], accO[nt]);
      }
      float u[4];
      u[0] = bflo(EC.u0[nt].x) - accU[0]; u[1] = bfhi(EC.u0[nt].x) - accU[1];
      u[2] = bflo(EC.u0[nt].y) - accU[2]; u[3] = bfhi(EC.u0[nt].y) - accU[3];
      const float e0 = EC.ed.x, e1 = EC.ed.y, e2 = EC.ed.z, e3 = EC.ed.w;
      uint2 pu, pd;
      int tb;
      if (d == 0) {
        tb = 16 * w + 4 * q4;
        pu.x = pack2(u[0], u[1]); pu.y = pack2(u[2], u[3]);
        pd.x = pack2(u[0] * e0, u[1] * e1); pd.y = pack2(u[2] * e2, u[3] * e3);
      } else {
        tb = 60 - 16 * w - 4 * q4;
        pu.x = pack2(u[3], u[2]); pu.y = pack2(u[1], u[0]);
        pd.x = pack2(u[3] * e3, u[2] * e2); pd.y = pack2(u[1] * e1, u[0] * e0);
      }
      *(uint2*)(U_lds + (16 * nt + i16) * 72 + tb) = pu;
      *(uint2*)(Ud_lds + (16 * nt + i16) * 72 + tb) = pd;
      accO[nt] *= EC.eg;
    }
    __syncthreads();
    scan_load_e(p, EC, min(n + 2, 67), b, h, d, slice, w, i16, q4);
    {
      bf16x8 Uf[2][2], Udf[2][2];
#pragma unroll
      for (int nt = 0; nt < 2; ++nt)
#pragma unroll
        for (int kk = 0; kk < 2; ++kk) {
          Uf[nt][kk] = *(const bf16x8*)(U_lds + (16 * nt + i16) * 72 + kk * 32 + q4 * 8);
          Udf[nt][kk] = *(const bf16x8*)(Ud_lds + (16 * nt + i16) * 72 + kk * 32 + q4 * 8);
        }
#pragma unroll
      for (int nt = 0; nt < 2; ++nt) {
#pragma unroll
        for (int mt = 0; mt < 2; ++mt) {
          Sacc[mt][nt] *= egl;
#pragma unroll
          for (int kk = 0; kk < 2; ++kk) Sacc[mt][nt] = mfma16(LC.kTf[mt][kk], Udf[nt][kk], Sacc[mt][nt]);
        }
#pragma unroll
        for (int kk = 0; kk < 2; ++kk) accO[nt] = mfma16(Uf[nt][kk], LC.pf[kk], accO[nt]);
      }
      scan_load_l(p, LC, min(n + 2, 67), b, h, d, w, i16, q4);
#pragma unroll
      for (int nt = 0; nt < 2; ++nt)
#pragma unroll
        for (int mt = 0; mt < 2; ++mt) {
          uint2 ps; ps.x = pack2(Sacc[mt][nt][0], Sacc[mt][nt][1]); ps.y = pack2(Sacc[mt][nt][2], Sacc[mt][nt][3]);
          *(uint2*)(S_lds + (16 * nt + i16) * 136 + 32 * w + 16 * mt + 4 * q4) = ps;
        }
      {
        const int r = 16 * w + i16;
        const int tok = d ? 63 - r : r;
        bf16_t* orow = Og + (size_t)(row0 + tok) * 512 + h * 128 + slice * 32;
        {
          u32x4 po; po[0] = pack2(accO[0][0], accO[0][1]); po[1] = pack2(accO[0][2], accO[0][3]); po[2] = pack2(accO[1][0], accO[1][1]); po[3] = pack2(accO[1][2], accO[1][3]);
          *(u32x4*)(orow + 8 * q4) = po;
        }
      }
    }
    __syncthreads();
  };
#pragma unroll 1
  for (int n2 = 0; n2 < 68; n2 += 2) {
    scan_step(n2, E0, L0);
    scan_step(n2 + 1, E1, L1);
  }
}

__device__ void phase_y(const Params& p, int l, int bid, int nblk) {
  int tid = threadIdx.x; asm volatile("" : "+v"(tid));
  const int lane = tid & 63, w = tid >> 6;
  const int nrows = (l == 3) ? LROWS : MROWS;
  const bf16_t* PA = p.PRE;
  const bf16_t* Of = p.PQKV;
  const bf16_t* Ob = p.PQKV + (size_t)MROWS * 512;
  float cw[3][8], gn[8];
  {
    const float* ca = p.conv_a + (size_t)l * 3 * 512 + lane * 8;
#pragma unroll
    for (int j = 0; j < 3; ++j) {
      float4 a = *(const float4*)(ca + j * 512), bq = *(const float4*)(ca + j * 512 + 4);
      cw[j][0] = a.x; cw[j][1] = a.y; cw[j][2] = a.z; cw[j][3] = a.w; cw[j][4] = bq.x; cw[j][5] = bq.y; cw[j][6] = bq.z; cw[j][7] = bq.w;
    }
    const float* gp = p.gdn_norm + l * 128 + (lane & 15) * 8;
    float4 a = *(const float4*)gp, bq = *(const float4*)(gp + 4);
    gn[0] = a.x; gn[1] = a.y; gn[2] = a.z; gn[3] = a.w; gn[4] = bq.x; gn[5] = bq.y; gn[6] = bq.z; gn[7] = bq.w;
  }
  {
    const int gw = bid * 4 + w, nw = nblk * 4;
    const int R0 = (int)(((long)gw * nrows) / nw), R1 = (int)(((long)(gw + 1) * nrows) / nw);
    auto segid = [&](int row) { return row < LROWS ? (row >> 6) : 512 + ((row - LROWS) >> 8); };
    auto loadmg = [&](int row, float* m, float* g2) {
      if (row < 0 || row >= MROWS) {
#pragma unroll
        for (int e = 0; e < 8; ++e) { m[e] = 0.f; g2[e] = 0.f; }
      } else {
        const bf16_t* pr = PA + (size_t)row * 1024 + lane * 16;
        const uint4 u0 = *(const uint4*)pr, u1 = *(const uint4*)(pr + 8);
        m[0] = bflo(u0.x); g2[0] = bfhi(u0.x); m[1] = bflo(u0.y); g2[1] = bfhi(u0.y); m[2] = bflo(u0.z); g2[2] = bfhi(u0.z); m[3] = bflo(u0.w); g2[3] = bfhi(u0.w);
        m[4] = bflo(u1.x); g2[4] = bfhi(u1.x); m[5] = bflo(u1.y); g2[5] = bfhi(u1.y); m[6] = bflo(u1.z); g2[6] = bfhi(u1.z); m[7] = bflo(u1.w); g2[7] = bfhi(u1.w);
      }
    };
    float mp[8], mc[8], mn[8], gc[8], gn2[8], gdum[8];
    loadmg(R0 - 1, mp, gdum); loadmg(R0, mc, gc);
#pragma unroll 1
    for (int row = R0; row < R1; ++row) {
      loadmg(row + 1, mn, gn2);
      const int sg = segid(row);
      const bool okp = row > 0 && segid(row - 1) == sg, okn = segid(row + 1) == sg;
      float zb[8], of[8], ob[8], ya[8], yb[8];
      unpack8(*(const uint4*)(p.PZB + (size_t)row * 512 + lane * 8), zb);
      unpack8(*(const uint4*)(Of + (size_t)row * 512 + lane * 8), of);
      unpack8(*(const uint4*)(Ob + (size_t)row * 512 + lane * 8), ob);
      float ss = 0.f;
#pragma unroll
      for (int e = 0; e < 8; ++e) {
        float cv = cw[0][e] * (okp ? mp[e] : 0.f) + cw[1][e] * mc[e] + cw[2][e] * (okn ? mn[e] : 0.f);
        ya[e] = gc[e] * cv;
        of[e] += ob[e]; ss += of[e] * of[e];
      }
      ss += __shfl_xor(ss, 1); ss += __shfl_xor(ss, 2); ss += __shfl_xor(ss, 4); ss += __shfl_xor(ss, 8);
      const float rs = rsqrtf(ss * (1.f / 128.f) + 1e-6f);
#pragma unroll
      for (int e = 0; e < 8; ++e) yb[e] = of[e] * rs * gn[e] * silu_f(zb[e]);
      *(uint4*)(p.H + kb_off(row, lane * 8)) = pack8(ya);
      *(uint4*)(p.H + kb_off(row, 512 + lane * 8)) = pack8(yb);
#pragma unroll
      for (int e = 0; e < 8; ++e) { mp[e] = mc[e]; mc[e] = mn[e]; gc[e] = gn2[e]; }
    }
  }
}

__device__ void phase_final(const Params& p, int bid, int nblk) {
  int tid = threadIdx.x; asm volatile("" : "+v"(tid));
  const int lane = tid & 63, w = tid >> 6;
  float4 fnv[4];
#pragma unroll
  for (int i = 0; i < 4; ++i) fnv[i] = *(const float4*)(p.final_norm + i * 256 + lane * 4);
  for (int row = bid * 4 + w; row < LROWS; row += nblk * 4) {
    float* src = p.out + (size_t)row * 1024;
    float4 v[4]; float ss = 0.f;
#pragma unroll
    for (int i = 0; i < 4; ++i) {
      v[i] = *(const float4*)(src + i * 256 + lane * 4);
      ss += v[i].x * v[i].x + v[i].y * v[i].y + v[i].z * v[i].z + v[i].w * v[i].w;
    }
#pragma unroll
    for (int o = 32; o >= 1; o >>= 1) ss += __shfl_xor(ss, o);
    const float rstd = rsqrtf(ss * (1.f / 1024.f) + 1e-6f);
#pragma unroll
    for (int i = 0; i < 4; ++i) {
      const int cidx = i * 256 + lane * 4;
      const float4 nv = fnv[i];
      float4 o; o.x = v[i].x * rstd * nv.x; o.y = v[i].y * rstd * nv.y; o.z = v[i].z * rstd * nv.z; o.w = v[i].w * rstd * nv.w;
      *(float4*)(src + cidx) = o;
    }
  }
}


#define XB_TMO      128
#define XB_XCNT(j)  (256  + 64 * (j))
#define XB_XSUB(j)  (1280 + 64 * (j))
#define XB_XGEN(j)  (2304 + 64 * (j))
#define XB_TOP      3328
#define XB_TOPGEN   3392
#define XCD_BAR_WORDS 3456
#define XB_SPIN_CAP (1u << 18)
#define LAS __attribute__((address_space(3)))
__device__ __forceinline__ unsigned xb_ld(unsigned* p)              { return __hip_atomic_load(p, __ATOMIC_RELAXED, __HIP_MEMORY_SCOPE_AGENT); }
__device__ __forceinline__ unsigned xb_add(unsigned* p, unsigned v) { return __hip_atomic_fetch_add(p, v, __ATOMIC_RELAXED, __HIP_MEMORY_SCOPE_AGENT); }
__device__ __forceinline__ unsigned xb_xcc_id() { return (unsigned)__builtin_amdgcn_s_getreg((3 << 11) | 20) & 0xFu; }
#define XB_SPIN(cond, bar) do { unsigned _sp = 0; while (cond) { __builtin_amdgcn_s_sleep(1); \
    if ((++_sp & 255u) == 0u) { if (xb_ld(&(bar)[XB_TMO])) break; if (_sp > XB_SPIN_CAP) { atomicAdd(&(bar)[XB_TMO], 1u); break; } } } } while (0)
struct XcdBarrier { unsigned* bar; unsigned x; volatile LAS unsigned* st; };
__device__ __forceinline__ XcdBarrier xcd_barrier_post(unsigned* bar, volatile LAS unsigned* st) {
    XcdBarrier b; b.bar = bar; b.x = xb_xcc_id(); b.st = st;
    if (threadIdx.x == 0) (void)xb_add(&bar[XB_XCNT(b.x)], 1u);
    return b;
}
__device__ __forceinline__ void xcd_barrier_complete(unsigned* bar, unsigned x, unsigned& nloc, unsigned& nx) {
    const unsigned G = gridDim.x * gridDim.y * gridDim.z;
    unsigned sum, cnt, mine, sp = 0u;
    for (;;) {
        sum = 0u; cnt = 0u; mine = 0u;
#pragma unroll
        for (unsigned j = 0; j < 16; ++j) { const unsigned c = xb_ld(&bar[XB_XCNT(j)]); sum += c; cnt += (c > 0u) ? 1u : 0u; mine = (j == x) ? c : mine; }
        if (sum == G) break;
        __builtin_amdgcn_s_sleep(1);
        if ((++sp & 255u) == 0u) { if (xb_ld(&bar[XB_TMO])) break; if (sp > XB_SPIN_CAP) { atomicAdd(&bar[XB_TMO], 1u); break; } }
    }
    nloc = mine > 0u ? mine : 1u; nx = cnt > 0u ? cnt : 1u;
}
__device__ __forceinline__ void xcd_barrier(const XcdBarrier& b) {
    asm volatile("s_waitcnt vmcnt(0)" ::: "memory");
    __syncthreads();
    if (threadIdx.x == 0) {
        unsigned* bar = b.bar;
        __builtin_amdgcn_s_waitcnt(0);
        unsigned nloc = b.st[0], nx = b.st[1];
        if (nloc == 0u) { xcd_barrier_complete(bar, b.x, nloc, nx); b.st[0] = nloc; b.st[1] = nx; }
        const unsigned old = xb_add(&bar[XB_XSUB(b.x)], 1u);
        const unsigned gen = old / nloc;
        if (old + 1u == (gen + 1u) * nloc) {
            __builtin_amdgcn_fence(__ATOMIC_RELEASE, "agent");
            asm volatile("s_waitcnt vmcnt(0)" ::: "memory");
            const unsigned og = xb_add(&bar[XB_TOP], 1u);
            const unsigned tg = og / nx;
            if (og + 1u == (tg + 1u) * nx) xb_add(&bar[XB_TOPGEN], 1u);
            else XB_SPIN(xb_ld(&bar[XB_TOPGEN]) == tg, bar);
            __builtin_amdgcn_fence(__ATOMIC_ACQUIRE, "agent");
            xb_add(&bar[XB_XGEN(b.x)], 1u);
            asm volatile("s_waitcnt vmcnt(0)" ::: "memory");
        } else {
            XB_SPIN(xb_ld(&bar[XB_XGEN(b.x)]) == gen, bar);
            __builtin_amdgcn_fence(__ATOMIC_ACQUIRE, "agent");
            asm volatile("s_waitcnt vmcnt(0)" ::: "memory");
        }
    }
    __syncthreads();
}

#if N_LAUNCH_MODE == 1
__device__ __forceinline__ void run_phase(const Params& p, int ph, char* smem, int bid, int nblk) {
  if (ph == 0) { phase_mod(p, smem, bid, nblk); __syncthreads(); conv_weights(p, 0, smem, bid, nblk); return; }
  if (ph == NPHASE - 1) { phase_final(p, bid, nblk); return; }
  const int l = (ph - 1) / 7;
#ifdef ONLY_S
  const int s = ONLY_S;
#else
  const int s = (ph - 1) % 7;
#endif
#ifndef PMASK
#define PMASK 127
#endif
#ifdef DUP_S
  if (s == DUP_S) {
    if (s == 0) phase_prep(p, l, smem, bid, nblk);
    else if (s == 1) phase_gemm<0>(p, l, smem, bid, nblk);
    else if (s == 2) phase_pre(p, l, smem, bid, nblk);
    else if (s == 3) phase_scan(p, l, smem, bid, nblk);
    else if (s == 4) phase_gemm<1>(p, l, smem, bid, nblk);
    else if (s == 5) phase_y(p, l, bid, nblk);
    __syncthreads();
  }
#endif
  if ((PMASK & 1) && s == 0) { if (nblk <= 256 && l > 0) conv_weights(p, l, smem, bid, nblk);
    phase_prep(p, l, smem, bid, nblk); }
  else if ((PMASK & 2) && s == 1) phase_gemm<0>(p, l, smem, bid, nblk);
  else if ((PMASK & 4) && s == 2) phase_pre(p, l, smem, bid, nblk);
  else if ((PMASK & 8) && s == 3) {
    if (bid >= 256 && l < 3) conv_weights(p, l + 1, smem, bid - 256, nblk - 256);
    else phase_scan(p, l, smem, bid, nblk);
  }
  else if ((PMASK & 16) && s == 4) phase_gemm<1>(p, l, smem, bid, nblk);
  else if ((PMASK & 32) && s == 5) phase_y(p, l, bid, nblk);
  else if ((PMASK & 64) && s == 6) phase_gemm<2>(p, l, smem, bid, nblk);
}

#endif
#if N_LAUNCH_MODE == 1
__global__ void __launch_bounds__(256, 2) fwd_kernel(Params p) {
  extern __shared__ __attribute__((aligned(16))) char smem[];
  const int bid = blockIdx.x, nblk = gridDim.x;
  volatile LAS unsigned* st = (volatile LAS unsigned*)(smem + LDS_BYTES);
  if (threadIdx.x == 0) { st[0] = 0u; st[1] = 0u; st[2] = 0u; st[3] = 0u; }
  __syncthreads();
  (void)xcd_barrier_post(p.bar, st);
  for (int ph = p.phase_lo; ph < p.phase_hi; ++ph) {
    run_phase(p, ph, smem, bid, nblk);
    if (ph + 1 < p.phase_hi) {
      if (ph == 0) cg::this_grid().sync();
      else {
        XcdBarrier xb; xb.bar = p.bar; xb.x = xb_xcc_id(); xb.st = (volatile LAS unsigned*)((char*)smem + LDS_BYTES);
        xcd_barrier(xb);
      }
    }
  }
}
#else
template <int S>
__global__ void __launch_bounds__(256, 2) phase_kernel(Params p, int l) {
  extern __shared__ __attribute__((aligned(16))) char smem[];
  const int bid = blockIdx.x, nblk = gridDim.x;
  if (S == 7) phase_mod(p, smem, bid, nblk);
  else if (S == 8) phase_final(p, bid, nblk);
  else if (S == 0) phase_prep(p, l, smem, bid, nblk);
  else if (S == 1) phase_gemm<0>(p, l, smem, bid, nblk);
  else if (S == 2) phase_pre(p, l, smem, bid, nblk);
  else if (S == 3) phase_scan(p, l, smem, bid, nblk);
  else if (S == 4) phase_gemm<1>(p, l, smem, bid, nblk);
  else if (S == 5) phase_y(p, l, bid, nblk);
  else if (S == 6) phase_gemm<2>(p, l, smem, bid, nblk);
}
template <int S> static void launch_phase(const Params& p, int l, int grid, hipStream_t stream) {
  static bool init = false;
  if (!init) { (void)hipFuncSetAttribute((const void*)phase_kernel<S>, hipFuncAttributeMaxDynamicSharedMemorySize, LDS_BYTES); init = true; }
  hipLaunchKernelGGL(phase_kernel<S>, dim3(grid), dim3(256), LDS_BYTES, stream, p, l);
}
#endif

extern "C" void kernel_launch(void* const* d_in, const int* in_sizes, int n_in, void* d_out, int out_size, void* d_ws, size_t ws_size, hipStream_t stream) {
  static int grid = 0;
  if (grid == 0) {
    int dev = 0, cus = 0, per_cu = 0;
    (void)hipGetDevice(&dev);
    (void)hipDeviceGetAttribute(&cus, hipDeviceAttributeMultiprocessorCount, dev);
#if N_LAUNCH_MODE == 1
    (void)hipFuncSetAttribute((const void*)fwd_kernel, hipFuncAttributeMaxDynamicSharedMemorySize, LDS_BYTES + 16);
    (void)hipOccupancyMaxActiveBlocksPerMultiprocessor(&per_cu, (const void*)fwd_kernel, 256, LDS_BYTES + 16);
    if (per_cu < 1) per_cu = 1;
    if (per_cu > 2) per_cu = 2;
#else
    per_cu = 2;
#endif
    if (cus <= 0) cus = 256;
    grid = cus * per_cu;
    (void)hipGetLastError();
  }
  Params p{};
  p.x = (const float*)d_in[0]; p.c = (const float*)d_in[1]; p.ctx = (const float*)d_in[2]; p.c_ctx = (const float*)d_in[3];
  p.norm_w = (const float*)d_in[4]; p.w_mod = (const float*)d_in[5]; p.b_mod = (const float*)d_in[6]; p.w_in = (const float*)d_in[7];
  p.conv_a = (const float*)d_in[8]; p.conv_qkv = (const float*)d_in[9]; p.a_log = (const float*)d_in[10]; p.dt_bias = (const float*)d_in[11];
  p.gdn_norm = (const float*)d_in[12]; p.w_out = (const float*)d_in[13]; p.final_norm = (const float*)d_in[14];
  p.out = (float*)d_out;
  char* ws = (char*)d_ws; size_t off = 0;
  auto take = [&](size_t bytes) { char* r = ws + off; off += (bytes + 255) & ~(size_t)255; return r; };
  p.bar = (unsigned*)take((size_t)XCD_BAR_WORDS * 4);
  p.XC = (float*)take((size_t)2048 * 1024 * 4);
  p.MOD = (float*)take((size_t)4 * 9 * 3072 * 4);
  p.BA = (float*)take((size_t)MROWS * 16 * 4);
  p.SC = (float*)take((size_t)NTASK_C * 2 * 192 * 4);
  p.WtIn = (bf16_t*)take((size_t)2 * NPADW * 1024 * 2);
  p.WtOut = (bf16_t*)take((size_t)2 * 1024 * 1024 * 2);
  p.H = (bf16_t*)take((size_t)MROWS * 1024 * 2);
  p.PQKV = (bf16_t*)take((size_t)MROWS * 1536 * 2);
  p.PZB = (bf16_t*)take((size_t)MROWS * 512 * 2);
  p.PRE = (bf16_t*)take((size_t)NTASK_C * PRE_TASK * 2);
  if (off > ws_size) { fprintf(stderr, "workspace too small: need %zu have %zu\n", off, ws_size); return; }
#if N_LAUNCH_MODE == 1
  p.phase_lo = 0; p.phase_hi = NPHASE;
  (void)hipMemsetAsync(p.bar, 0, (size_t)XCD_BAR_WORDS * 4, stream);
  void* args[] = {&p};
  hipError_t e = hipLaunchCooperativeKernel((const void*)fwd_kernel, dim3(grid), dim3(256), args, LDS_BYTES + 16, stream);
  if (e != hipSuccess) fprintf(stderr, "cooperative launch failed: %s (grid %d)\n", hipGetErrorString(e), grid);
#else
  p.phase_lo = 0; p.phase_hi = 0;
  launch_phase<7>(p, 0, grid, stream);
  for (int l = 0; l < 4; ++l) {
    launch_phase<0>(p, l, grid, stream);
    launch_phase<1>(p, l, grid, stream);
    launch_phase<2>(p, l, grid, stream);
    launch_phase<3>(p, l, grid, stream);
    launch_phase<4>(p, l, grid, stream);
    launch_phase<5>(p, l, grid, stream);
    launch_phase<6>(p, l, grid, stream);
  }
  launch_phase<8>(p, 0, grid, stream);
#endif
}
```
